# Optimizing an MI355X kernel written in HIP

```python
import math
import jax, jax.numpy as jnp
from jax import lax
import numpy as np

D_MODEL = 2048
BATCH = 1
SEQ = 8192
DEPTH = 2
DEC_BATCH = 2
DEC_SEQ = 8192
PAST_LEN = 128

SSM_WIDTH = D_MODEL
SSM_GROUP = 16
SSM_GROUPS = SSM_WIDTH // SSM_GROUP
SSM_STATE = 64
POOL_WIDTH = D_MODEL
POOL_WINDOWS = (2, 4, 8, 16)
POOL_GROUPS = len(POOL_WINDOWS)
POOL_GROUP_WIDTH = POOL_WIDTH // POOL_GROUPS
N_BRANCHES = 2
IN_COLS = 2 * SSM_WIDTH + 2 * POOL_WIDTH + N_BRANCHES * D_MODEL
EPS = 1e-6
DT_MIN = 1e-3
DT_MAX = 1e-1
LAM_RE_MAX = -1e-4

kernel_name = "hybrid_s5_pool_gated_encoder"


def rms_norm(x, w):
    x32 = x.astype(jnp.float32)
    y = x32 * lax.rsqrt(jnp.mean(x32 * x32, axis=-1, keepdims=True) + EPS)
    return (y * w.astype(jnp.float32)).astype(x.dtype)


def _cmul(ar, ai, br, bi):
    return ar * br - ai * bi, ar * bi + ai * br


def _scan_combine(left, right):
    a1r, a1i, b1r, b1i = left
    a2r, a2i, b2r, b2i = right
    ar, ai = _cmul(a2r, a2i, a1r, a1i)
    br, bi = _cmul(a2r, a2i, b1r, b1i)
    return ar, ai, br + b2r, bi + b2i


def s5_direction(u, lam_re, lam_im, log_dt, b_re, b_im, c_re, c_im, reverse):
    f32 = jnp.float32
    lr = jnp.minimum(lam_re.astype(f32), LAM_RE_MAX)
    li = lam_im.astype(f32)
    dt = jnp.exp(log_dt.astype(f32))[:, None]
    mag = jnp.exp(lr * dt)
    ar = mag * jnp.cos(li * dt)
    ai = mag * jnp.sin(li * dt)
    den = lr * lr + li * li
    nr = ((ar - 1.0) * lr + ai * li) / den
    ni = (ai * lr - (ar - 1.0) * li) / den
    bbr, bbi = _cmul(nr[..., None], ni[..., None], b_re.astype(f32), b_im.astype(f32))
    bu_r = jnp.einsum('blgc,gpc->blgp', u, bbr)
    bu_i = jnp.einsum('blgc,gpc->blgp', u, bbi)
    a_r = jnp.broadcast_to(ar, bu_r.shape)
    a_i = jnp.broadcast_to(ai, bu_r.shape)
    _, _, h_r, h_i = lax.associative_scan(_scan_combine, (a_r, a_i, bu_r, bu_i), reverse=reverse, axis=1)
    return (jnp.einsum('blgp,gcp->blgc', h_r, c_re.astype(f32))
            - jnp.einsum('blgp,gcp->blgc', h_i, c_im.astype(f32)))


def s5_branch(u, lam_re, lam_im, log_dt, b_re, b_im, c_re, c_im, d_skip, glu_w, glu_b):
    f32 = jnp.float32
    bsz, L, _ = u.shape
    u32 = u.astype(f32).reshape(bsz, L, SSM_GROUPS, SSM_GROUP)
    y = (s5_direction(u32, lam_re[0], lam_im[0], log_dt[0], b_re[0], b_im[0], c_re[0], c_im[0], False)
         + s5_direction(u32, lam_re[1], lam_im[1], log_dt[1], b_re[1], b_im[1], c_re[1], c_im[1], True)
         + d_skip.astype(f32).reshape(SSM_GROUPS, SSM_GROUP) * u32)
    y = jax.nn.gelu(y.reshape(bsz, L, SSM_WIDTH))
    return y * jax.nn.sigmoid(y @ glu_w.astype(f32) + glu_b.astype(f32))


def centred_window_mean(u, w):
    L = u.shape[1]
    cs = jnp.concatenate([jnp.zeros_like(u[:, :1]), lax.cumsum(u, axis=1)], axis=1)
    pos = jnp.arange(L)
    lo = jnp.maximum(pos - w // 2, 0)
    hi = jnp.minimum(pos + (w - w // 2), L)
    s = jnp.take(cs, hi, axis=1) - jnp.take(cs, lo, axis=1)
    cnt = (hi - lo).astype(u.dtype)
    return s / cnt[None, :, None]


def pool_branch(u, pool_w, pool_scale):
    u32 = u.astype(jnp.float32)
    parts = []
    for g, w in enumerate(POOL_WINDOWS):
        ug = u32[..., g * POOL_GROUP_WIDTH:(g + 1) * POOL_GROUP_WIDTH]
        parts.append(centred_window_mean(ug, w) - ug)
    p = jnp.stack(parts, axis=2)
    y = jnp.einsum('blgc,gcd->blgd', p, pool_w.astype(jnp.float32))
    return y.reshape(u.shape) * pool_scale.astype(jnp.float32)


def mixer_layer(x, norm_w, w_in, gate_b, lam_re, lam_im, log_dt, b_re, b_im, c_re, c_im,
                d_skip, glu_w, glu_b, pool_w, pool_scale, proj_a, proj_b, w_out):
    dt = x.dtype
    h = rms_norm(x, norm_w)
    proj = h @ w_in
    o = 0
    u_a = proj[..., o:o + SSM_WIDTH]; o += SSM_WIDTH
    z_a = proj[..., o:o + SSM_WIDTH]; o += SSM_WIDTH
    u_b = proj[..., o:o + POOL_WIDTH]; o += POOL_WIDTH
    z_b = proj[..., o:o + POOL_WIDTH]; o += POOL_WIDTH
    g_a = proj[..., o:o + D_MODEL]; o += D_MODEL
    g_b = proj[..., o:o + D_MODEL]
    y_a = (s5_branch(u_a, lam_re, lam_im, log_dt, b_re, b_im, c_re, c_im, d_skip, glu_w, glu_b)
           * jax.nn.silu(z_a.astype(jnp.float32))).astype(dt)
    y_b = (pool_branch(u_b, pool_w, pool_scale) * jax.nn.silu(z_b.astype(jnp.float32))).astype(dt)
    merged = (jax.nn.sigmoid(g_a + gate_b[0]) * (y_a @ proj_a)
              + jax.nn.sigmoid(g_b + gate_b[1]) * (y_b @ proj_b))
    return x + merged @ w_out


def trunk(x, norm_w, w_in, gate_b, ssm_lam_re, ssm_lam_im, ssm_log_dt, ssm_b_re, ssm_b_im,
          ssm_c_re, ssm_c_im, ssm_d, glu_w, glu_b, pool_w, pool_scale, proj_a, proj_b, w_out, final_norm_w):
    for l in range(DEPTH):
        x = mixer_layer(x, norm_w[l], w_in[l], gate_b[l], ssm_lam_re[l], ssm_lam_im[l], ssm_log_dt[l],
                        ssm_b_re[l], ssm_b_im[l], ssm_c_re[l], ssm_c_im[l], ssm_d[l], glu_w[l], glu_b[l],
                        pool_w[l], pool_scale[l], proj_a[l], proj_b[l], w_out[l])
    return rms_norm(x, final_norm_w)


def setup_inputs(seed: int = 0) -> dict:
    key = jax.random.key(seed)
    ks = jax.random.split(key, 24)
    f32 = jnp.float32
    nrm = lambda k, shape, s: jax.random.normal(k, shape, f32) * s
    G, P, C = SSM_GROUPS, SSM_STATE, SSM_GROUP
    lam_im_base = jnp.pi * jnp.arange(P, dtype=f32)
    return {
        "x_prompt": jax.random.normal(ks[0], (BATCH, SEQ, D_MODEL), f32),
        "x_sample": jax.random.normal(ks[1], (DEC_BATCH, DEC_SEQ, D_MODEL), f32),
        "norm_w": 1.0 + nrm(ks[2], (DEPTH, D_MODEL), 0.05),
        "w_in": nrm(ks[3], (DEPTH, D_MODEL, IN_COLS), D_MODEL ** -0.5),
        "gate_b": nrm(ks[4], (DEPTH, N_BRANCHES, D_MODEL), 0.02),
        "ssm_lam_re": -0.5 + nrm(ks[5], (DEPTH, 2, G, P), 0.01),
        "ssm_lam_im": lam_im_base + nrm(ks[6], (DEPTH, 2, G, P), 0.01),
        "ssm_log_dt": jax.random.uniform(ks[7], (DEPTH, 2, G), f32, math.log(DT_MIN), math.log(DT_MAX)),
        "ssm_b_re": nrm(ks[8], (DEPTH, 2, G, P, C), (2.0 * C) ** -0.5),
        "ssm_b_im": nrm(ks[9], (DEPTH, 2, G, P, C), (2.0 * C) ** -0.5),
        "ssm_c_re": nrm(ks[10], (DEPTH, 2, G, C, P), 0.5 ** 0.5),
        "ssm_c_im": nrm(ks[11], (DEPTH, 2, G, C, P), 0.5 ** 0.5),
        "ssm_d": nrm(ks[12], (DEPTH, SSM_WIDTH), 1.0),
        "glu_w": nrm(ks[13], (DEPTH, SSM_WIDTH, SSM_WIDTH), SSM_WIDTH ** -0.5),
        "glu_b": nrm(ks[14], (DEPTH, SSM_WIDTH), 0.02),
        "pool_w": nrm(ks[15], (DEPTH, POOL_GROUPS, POOL_GROUP_WIDTH, POOL_GROUP_WIDTH), POOL_GROUP_WIDTH ** -0.5),
        "pool_scale": 1.0 + nrm(ks[16], (DEPTH, POOL_WIDTH), 0.1),
        "proj_a": nrm(ks[17], (DEPTH, SSM_WIDTH, D_MODEL), SSM_WIDTH ** -0.5),
        "proj_b": nrm(ks[18], (DEPTH, POOL_WIDTH, D_MODEL), POOL_WIDTH ** -0.5),
        "w_out": nrm(ks[19], (DEPTH, D_MODEL, D_MODEL), D_MODEL ** -0.5),
        "final_norm_w": 1.0 + nrm(ks[20], (D_MODEL,), 0.05),
    }


def reference(x_prompt, x_sample, norm_w, w_in, gate_b, ssm_lam_re, ssm_lam_im, ssm_log_dt, ssm_b_re,
              ssm_b_im, ssm_c_re, ssm_c_im, ssm_d, glu_w, glu_b, pool_w, pool_scale, proj_a, proj_b,
              w_out, final_norm_w):
    y_prompt = trunk(x_prompt, norm_w, w_in, gate_b, ssm_lam_re, ssm_lam_im, ssm_log_dt, ssm_b_re, ssm_b_im,
                     ssm_c_re, ssm_c_im, ssm_d, glu_w, glu_b, pool_w, pool_scale, proj_a, proj_b, w_out,
                     final_norm_w)
    y_sample = trunk(x_sample, norm_w, w_in, gate_b, ssm_lam_re, ssm_lam_im, ssm_log_dt, ssm_b_re, ssm_b_im,
                     ssm_c_re, ssm_c_im, ssm_d, glu_w, glu_b, pool_w, pool_scale, proj_a, proj_b, w_out,
                     final_norm_w)
    return (y_prompt, y_sample)
```

```cpp
#include <hip/hip_runtime.h>
#include <hip/hip_cooperative_groups.h>
#include <cstdio>
#include <cstdint>
namespace cg = cooperative_groups;


#define LAS __attribute__((address_space(3)))
typedef unsigned short bf16_t;
typedef short bf16x8 __attribute__((ext_vector_type(8)));
typedef float f32x4 __attribute__((ext_vector_type(4)));
typedef unsigned u32x4 __attribute__((ext_vector_type(4)));

constexpr int NTOK = 24576, DM = 2048, SEQL = 8192, INC = 12288;
constexpr int TCH = 32, NCHK = 256, SGRP = 128, UROWS = 768, UKK = 768;
constexpr int NTHREADS = 512, LDS_BYTES = 131072 + 16;
constexpr size_t MiB = 1048576;
constexpr size_t OFF_WINT = 0, OFF_GLUT = 48 * MiB, OFF_PAT = 56 * MiB, OFF_PBT = 64 * MiB, OFF_WOT = 72 * MiB, OFF_POOLT = 80 * MiB,
                 OFF_MG = 82 * MiB, OFF_BT = 178 * MiB, OFF_H = 210 * MiB, OFF_RA = 306 * MiB, OFF_RB = 450 * MiB, OFF_RC = 546 * MiB,
                 OFF_RD = 642 * MiB, WS_END = 738 * MiB;

struct Params {
    const float* x_prompt; const float* x_sample; const float* norm_w; const float* w_in; const float* gate_b;
    const float* lam_re; const float* lam_im; const float* log_dt; const float* b_re; const float* b_im; const float* c_re; const float* c_im;
    const float* ssm_d; const float* glu_w; const float* glu_b; const float* pool_w; const float* pool_scale;
    const float* proj_a; const float* proj_b; const float* w_out; const float* final_norm_w;
    float* out; unsigned char* ws; int ph_lo, ph_hi;
};

typedef __bf16 bf16x2_t __attribute__((ext_vector_type(2)));
typedef float f32x2_t __attribute__((ext_vector_type(2)));
__device__ __forceinline__ unsigned pk_bf16(float lo, float hi) { f32x2_t v = {lo, hi}; bf16x2_t b = __builtin_convertvector(v, bf16x2_t); return __builtin_bit_cast(unsigned, b); }
__device__ __forceinline__ float bf_lo(unsigned w) { return __uint_as_float(w << 16); }
__device__ __forceinline__ float bf_hi(unsigned w) { return __uint_as_float(w & 0xffff0000u); }
__device__ __forceinline__ float sigmoidf_(float x) { return __builtin_amdgcn_rcpf(1.0f + __expf(-x)); }
__device__ __forceinline__ float siluf_(float x) { return x * sigmoidf_(x); }
__device__ __forceinline__ float gelu_tanh_(float x) { return x * sigmoidf_(1.5957691216057308f * (x + 0.044715f * x * x * x)); }
__device__ __forceinline__ void unpack8(const u32x4 w, float (&v)[8]) { v[0] = bf_lo(w.x); v[1] = bf_hi(w.x); v[2] = bf_lo(w.y); v[3] = bf_hi(w.y); v[4] = bf_lo(w.z); v[5] = bf_hi(w.z); v[6] = bf_lo(w.w); v[7] = bf_hi(w.w); }
__device__ __forceinline__ u32x4 pack8(const float (&v)[8]) { u32x4 w; w.x = pk_bf16(v[0], v[1]); w.y = pk_bf16(v[2], v[3]); w.z = pk_bf16(v[4], v[5]); w.w = pk_bf16(v[6], v[7]); return w; }
__device__ __forceinline__ void lam_pow(float lr, float li, float dt, int n, float& re, float& im) {
    const float a = lr * dt, b = li * dt; const float m = expf(a * (float)n);
    const double ang = (double)b * (double)n; const double k = rint(ang * 0.15915494309189535); const float r = (float)(ang - k * 6.283185307179586);
    re = m * cosf(r); im = m * sinf(r);
}

namespace pg8 {
#ifndef EPI_NP1
#define EPI_NP1 4
#endif
#ifndef EPI_NP2
#define EPI_NP2 4
#endif
#ifndef EPI_NPF
#define EPI_NPF 4
#endif
#ifndef EPI_NPR
#define EPI_NPR 4
#endif
constexpr int BM = 256, BK = 64, HALF = 128, HTB = HALF * BK * 2, STAGE_BYTES = 8 * HTB, NXCD = 8, WGM = 8;
__device__ __forceinline__ int lds_byte(int r, int c) { const int st = (r >> 4) * 2 + (c >> 5), rr = r & 15, cc = c & 31, ob = rr * 64 + cc * 2; return st * 1024 + (ob ^ (((ob >> 9) & 1) << 5)); }
__device__ __forceinline__ void stage_rc(int b, int& R, int& C) { const int st = b / 1024, sb = b % 1024, swz = sb ^ (((sb >> 9) & 1) << 5); R = (st >> 1) * 16 + swz / 64; C = (st & 1) * 32 + (swz % 64) / 2; }
__device__ __forceinline__ int perm32(int rho) { const int n = rho >> 4, i = rho & 15; return 8 * (i >> 2) + 4 * n + (i & 3); }

struct Unit { int pm, pn, b; };
struct Gemm { const bf16_t* A; const bf16_t* Bt; int lda, ldb, K, kgrp; size_t sA, sB;
    __device__ __forceinline__ const char* a_ptr(const Unit& u) const { return (const char*)(A + (size_t)u.b * sA + (size_t)u.pm * BM * (kgrp == 3 ? 16 : lda) + (kgrp == 1 ? (u.pn >> 1) * K : 0)); }
    __device__ __forceinline__ const char* b_ptr(const Unit& u) const { return (const char*)(Bt + (size_t)u.b * sB + (size_t)u.pn * (kgrp == 2 ? 128 : BM) * ldb); }
};
struct StaticOrder {
    int nM, nN, nwg, G, c, rev = 0;
    __device__ void init(int M, int N, int G_, int c_) { nM = M / BM; nN = N / BM; nwg = nM * nN; G = G_; c = c_; }
    __device__ bool next(int i, Unit& u) const {
        const long L = (long)i * G + c; if (L >= nwg) return false;
        int wgid = (int)L; { const int q = nwg / NXCD, r = nwg % NXCD, xcd = wgid % NXCD, off = wgid / NXCD; wgid = (xcd < r ? xcd * (q + 1) : r * (q + 1) + (xcd - r) * q) + off; }
        if (rev) wgid = nwg - 1 - wgid;
        const int nig = WGM * nN, gid = wgid / nig, fm = gid * WGM, gsz = (nM - fm) < WGM ? (nM - fm) : WGM;
        u.pm = fm + ((wgid % nig) % gsz); u.pn = (wgid % nig) / gsz; u.b = 0; return true;
    }
};
struct BatchOrder {
    int nM, nN, per, nwg, G, c, rev = 0;
    __device__ void init(int nB, int nM_, int nN_, int G_, int c_) { nM = nM_; nN = nN_; per = nM_ * nN_; nwg = nB * per; G = G_; c = c_; }
    __device__ bool next(int i, Unit& u) const {
        const long L = (long)i * G + c; if (L >= nwg) return false;
        int wgid = (int)L; { const int q = nwg / NXCD, r = nwg % NXCD, xcd = wgid % NXCD, off = wgid / NXCD; wgid = (xcd < r ? xcd * (q + 1) : r * (q + 1) + (xcd - r) * q) + off; }
        if (rev) wgid = nwg - 1 - wgid;
        u.b = wgid / per; const int r2 = wgid % per; u.pm = r2 % nM; u.pn = r2 / nM; return true;
    }
};

enum { E_G1A = 0, E_G1B, E_G1C, E_S5P2, E_GLU, E_POOL, E_PA, E_PB, E_RAW, E_MERGE, E_RES0, E_RES1 };
template <int MODE> struct EpiB {
    static constexpr bool PERM = true;
    bf16_t* O0; bf16_t* O1; const bf16_t* X0; const float* bias; const float* XF1 = nullptr; float* XO = nullptr;
    __device__ __forceinline__ void operator()(const f32x4 (&acc)[2][2][4][2], const Unit& u, int wr, int wc, int fr, int fq) const {
        const int colb = u.pn * BM + wc * 64 + 8 * fq;
        f32x4 bv[2][2];
        if (MODE == E_G1C || MODE == E_GLU || MODE == E_POOL) {
#pragma unroll
            for (int bj = 0; bj < 2; ++bj) { bv[bj][0] = *(const f32x4*)(bias + colb + bj * 32); bv[bj][1] = *(const f32x4*)(bias + colb + bj * 32 + 4); }
        }
        if (MODE == E_RES0) {
            const float* X = (u.pm < 32) ? bias : XF1;
            const size_t lane_off = (size_t)(u.pm * BM + wr * 64 + fr) * DM + colb;
#define EPI_OFF(s_) (lane_off + (size_t)((((s_) >> 3) & 1) * HALF + (((s_) >> 1) & 3) * 16) * DM + ((s_) & 1) * 32)
#pragma unroll
            for (int r0 = 0; r0 < 16; r0 += EPI_NPR) {
                f32x4 xa[EPI_NPR], xb[EPI_NPR];
#pragma unroll
                for (int q = 0; q < EPI_NPR; ++q) { xa[q] = *(const f32x4*)(X + EPI_OFF(r0 + q)); xb[q] = *(const f32x4*)(X + EPI_OFF(r0 + q) + 4); }
#pragma unroll
                for (int q = 0; q < EPI_NPR; ++q) { const int st = r0 + q, ai = st >> 3, m = (st >> 1) & 3, bj = st & 1; xa[q] += acc[ai][bj][m][0]; xb[q] += acc[ai][bj][m][1]; }
#pragma unroll
                for (int q = 0; q < EPI_NPR; ++q) { u32x4 w; w.x = pk_bf16(xa[q][0], xa[q][1]); w.y = pk_bf16(xa[q][2], xa[q][3]); w.z = pk_bf16(xb[q][0], xb[q][1]); w.w = pk_bf16(xb[q][2], xb[q][3]);
                    *(u32x4*)(O0 + EPI_OFF(r0 + q)) = w; }
            }
#undef EPI_OFF
            return;
        }
        if (MODE == E_RES1) {
            const size_t lane_off = (size_t)(u.pm * BM + wr * 64 + fr) * DM + colb;
#define EPI_OFF(s_) (lane_off + (size_t)((((s_) >> 3) & 1) * HALF + (((s_) >> 1) & 3) * 16) * DM + ((s_) & 1) * 32)
#pragma unroll
            for (int r0 = 0; r0 < 16; r0 += 4) {
                u32x4 lx[4]; f32x4 ya[4], yb[4];
#pragma unroll
                for (int q = 0; q < 4; ++q) lx[q] = *(const u32x4*)(X0 + EPI_OFF(r0 + q));
#pragma unroll
                for (int q = 0; q < 4; ++q) { const int st = r0 + q, ai = st >> 3, m = (st >> 1) & 3, bj = st & 1; float a[8]; unpack8(lx[q], a);
                    ya[q] = acc[ai][bj][m][0] + (f32x4){a[0], a[1], a[2], a[3]}; yb[q] = acc[ai][bj][m][1] + (f32x4){a[4], a[5], a[6], a[7]}; }
#pragma unroll
                for (int q = 0; q < 4; ++q) { *(f32x4*)(XO + EPI_OFF(r0 + q)) = ya[q]; *(f32x4*)(XO + EPI_OFF(r0 + q) + 4) = yb[q]; }
            }
#undef EPI_OFF
            return;
        }
        if (MODE == E_RAW) {
#pragma unroll
            for (int ai = 0; ai < 2; ++ai)
#pragma unroll
                for (int m = 0; m < 4; ++m)
#pragma unroll
                    for (int bj = 0; bj < 2; ++bj) { float v[8];
#pragma unroll
                        for (int j = 0; j < 4; ++j) { v[j] = acc[ai][bj][m][0][j]; v[4 + j] = acc[ai][bj][m][1][j]; }
                        *(u32x4*)(O0 + (size_t)(u.pm * BM + ai * HALF + wr * 64 + m * 16 + fr) * DM + colb + bj * 32) = pack8(v); }
            return;
        }
        if (MODE == E_MERGE) {
            const int d0 = u.pn * 128 + wc * 32 + 8 * fq;
            const f32x4 ba0 = *(const f32x4*)(bias + d0), ba1 = *(const f32x4*)(bias + d0 + 4), bb0 = *(const f32x4*)(bias + DM + d0), bb1 = *(const f32x4*)(bias + DM + d0 + 4);
            const size_t lane_off = (size_t)(u.pm * BM + wr * 64 + fr) * DM + d0;
#pragma unroll
            for (int ai = 0; ai < 2; ++ai) {
                u32x4 la[4], lb[4];
#pragma unroll
                for (int m = 0; m < 4; ++m) { const size_t idx = lane_off + (size_t)(ai * HALF + m * 16) * DM; la[m] = *(const u32x4*)(O0 + idx); lb[m] = *(const u32x4*)(X0 + idx); }
#pragma unroll
                for (int m = 0; m < 4; ++m) { float a[8], b[8], v[8]; unpack8(la[m], a); unpack8(lb[m], b);
#pragma unroll
                    for (int j = 0; j < 4; ++j) {
                        v[j] = sigmoidf_(acc[ai][0][m][0][j] + ba0[j]) * a[j] + sigmoidf_(acc[ai][1][m][0][j] + bb0[j]) * b[j];
                        v[4 + j] = sigmoidf_(acc[ai][0][m][1][j] + ba1[j]) * a[4 + j] + sigmoidf_(acc[ai][1][m][1][j] + bb1[j]) * b[4 + j]; }
                    la[m] = pack8(v); }
#pragma unroll
                for (int m = 0; m < 4; ++m) *(u32x4*)(O0 + lane_off + (size_t)(ai * HALF + m * 16) * DM) = la[m];
            }
            return;
        }
        if (MODE == E_GLU || MODE == E_POOL || MODE == E_PA || MODE == E_PB) {
            constexpr bool TWO = (MODE == E_GLU || MODE == E_PB);
            constexpr int NP = TWO ? EPI_NP2 : EPI_NP1;
            bf16_t* Ob = (MODE == E_PB) ? O1 : O0;
            const size_t lane_off = (size_t)(u.pm * BM + wr * 64 + fr) * DM + colb;
            const size_t lane_offx = ((size_t)(colb >> 4) * NTOK + (u.pm * BM + wr * 64 + fr)) * 16 + (colb & 15);
#define EPI_OFF(s_) (lane_off + (size_t)((((s_) >> 3) & 1) * HALF + (((s_) >> 1) & 3) * 16) * DM + ((s_) & 1) * 32)
#pragma unroll
            for (int r0 = 0; r0 < 16; r0 += NP) {
                u32x4 la[NP], lb[NP];
#pragma unroll
                for (int q = 0; q < NP; ++q) { la[q] = *(const u32x4*)(Ob + EPI_OFF(r0 + q));
                    if (MODE == E_GLU) { const int s_ = r0 + q;
                        lb[q] = *(const u32x4*)(X0 + lane_offx + (size_t)(((s_ >> 3) & 1) * HALF + ((s_ >> 1) & 3) * 16) * 16 + (size_t)(s_ & 1) * 2 * NTOK * 16); }
                    else if (TWO) lb[q] = *(const u32x4*)(X0 + EPI_OFF(r0 + q)); }
#pragma unroll
                for (int q = 0; q < NP; ++q) {
                    const int st = r0 + q, ai = st >> 3, m = (st >> 1) & 3, bj = st & 1;
                    float v[8], a[8], b[8];
#pragma unroll
                    for (int j = 0; j < 4; ++j) { v[j] = acc[ai][bj][m][0][j]; v[4 + j] = acc[ai][bj][m][1][j]; }
                    unpack8(la[q], a);
                    if (TWO) unpack8(lb[q], b);
                    if (MODE == E_GLU) {
#pragma unroll
                        for (int j = 0; j < 4; ++j) { v[j] = b[j] * sigmoidf_(v[j] + bv[bj][0][j]) * a[j]; v[4 + j] = b[4 + j] * sigmoidf_(v[4 + j] + bv[bj][1][j]) * a[4 + j]; }
                    } else if (MODE == E_POOL) {
#pragma unroll
                        for (int j = 0; j < 4; ++j) { v[j] = v[j] * bv[bj][0][j] * a[j]; v[4 + j] = v[4 + j] * bv[bj][1][j] * a[4 + j]; }
                    } else if (MODE == E_PA) {
#pragma unroll
                        for (int j = 0; j < 8; ++j) v[j] *= a[j];
                    } else {
#pragma unroll
                        for (int j = 0; j < 8; ++j) v[j] = b[j] + a[j] * v[j];
                    }
                    la[q] = pack8(v);
                }
#pragma unroll
                for (int q = 0; q < NP; ++q) *(u32x4*)(Ob + EPI_OFF(r0 + q)) = la[q];
            }
#undef EPI_OFF
            return;
        }
#pragma unroll
        for (int ai = 0; ai < 2; ++ai)
#pragma unroll
            for (int m = 0; m < 4; ++m) {
                const int row = u.pm * BM + ai * HALF + wr * 64 + m * 16 + fr;
#pragma unroll
                for (int bj = 0; bj < 2; ++bj) {
                    const int col = colb + bj * 32;
                    float v[8];
#pragma unroll
                    for (int j = 0; j < 4; ++j) { v[j] = acc[ai][bj][m][0][j]; v[4 + j] = acc[ai][bj][m][1][j]; }
                    if (MODE == E_G1A || MODE == E_G1B || MODE == E_G1C) {
                        const int seg = u.pn >> 3, cc = col & 2047;
                        if (MODE == E_G1C) {
#pragma unroll
                            for (int j = 0; j < 4; ++j) { v[j] = sigmoidf_(v[j] + bv[bj][0][j]); v[4 + j] = sigmoidf_(v[4 + j] + bv[bj][1][j]); }
                        } else if (seg == 1) {
#pragma unroll
                            for (int j = 0; j < 8; ++j) v[j] = siluf_(v[j]);
                        }
                        bf16_t* dst;
                        if (MODE == E_G1A && seg == 0) {
                            const int g = cc >> 4, c0 = cc & 15, sq = row >> 13, tl = row & 8191, ch = tl >> 5, s = tl & 31;
                            dst = O0 + ((size_t)(g * UROWS + sq * NCHK + ch) * UKK + s * 16 + c0);
                        } else dst = (seg ? O1 : O0) + (size_t)row * DM + cc;
                        *(u32x4*)dst = pack8(v);
                    } else if (MODE == E_S5P2) {
                        const int ch = row & 255, t = col >> 4, c0 = col & 15;
                        const size_t tok = (size_t)u.pm * SEQL + ch * TCH + t;
#pragma unroll
                        for (int j = 0; j < 8; ++j) v[j] = gelu_tanh_(v[j]);
                        *(u32x4*)(O0 + ((size_t)u.b * NTOK + tok) * 16 + c0) = pack8(v);
                    }
                }
                asm volatile("" ::: "memory");
            }
    }
};
enum { F_S5P1 = 0, F_WOUT };
template <int MODE> struct EpiF {
    static constexpr bool PERM = false;
    float* C; const float* X0; const float* X1;
    __device__ __forceinline__ void operator()(const f32x4 (&acc)[2][2][4][2], const Unit& u, int wr, int wc, int fr, int fq) const {
        const int col0 = u.pn * BM + wc * 32 + 4 * fq;
        const float* X = (u.pm < 32) ? X0 : X1;
        if (MODE == F_WOUT) {
            const size_t lane_off = (size_t)(u.pm * BM + wr * 64 + fr) * DM + col0;
#define EPI_OFF(s_) (lane_off + (size_t)((((s_) >> 3) & 1) * HALF + (((s_) >> 1) & 3) * 16) * DM + ((s_) & 1) * HALF)
#pragma unroll
            for (int r0 = 0; r0 < 16; r0 += EPI_NPF) {
                f32x4 xr[EPI_NPF][2];
#pragma unroll
                for (int q = 0; q < EPI_NPF; ++q)
#pragma unroll
                    for (int n = 0; n < 2; ++n) xr[q][n] = *(const f32x4*)(X + EPI_OFF(r0 + q) + n * 16);
#pragma unroll
                for (int q = 0; q < EPI_NPF; ++q) { const int st = r0 + q, ai = st >> 3, m = (st >> 1) & 3, bj = st & 1;
#pragma unroll
                    for (int n = 0; n < 2; ++n) xr[q][n] += acc[ai][bj][m][n]; }
#pragma unroll
                for (int q = 0; q < EPI_NPF; ++q)
#pragma unroll
                    for (int n = 0; n < 2; ++n) *(f32x4*)(C + EPI_OFF(r0 + q) + n * 16) = xr[q][n];
            }
#undef EPI_OFF
            return;
        }
#pragma unroll
        for (int ai = 0; ai < 2; ++ai)
#pragma unroll
            for (int m = 0; m < 4; ++m) {
                const int row = u.pm * BM + ai * HALF + wr * 64 + m * 16 + fr;
#pragma unroll
                for (int bj = 0; bj < 2; ++bj)
#pragma unroll
                    for (int n = 0; n < 2; ++n) {
                        const int col = col0 + bj * HALF + n * 16;
                        *(f32x4*)(C + ((size_t)u.b * UROWS + row) * 256 + col) = acc[ai][bj][m][n];
                    }
                asm volatile("" ::: "memory");
            }
    }
};

#ifndef PG8_SP2
#define PG8_SP2 1
#endif
#ifndef PG8_ALIGN
#define PG8_ALIGN 1
#endif
template <class Epi, class Sched>
__device__ __forceinline__ void gemm_phase(LAS unsigned char* lds, const int tid, const Gemm g, const Sched& S, const Epi& E) {
    constexpr bool SP2 = PG8_SP2 != 0, ALIGN_EPI = PG8_ALIGN != 0;
    const int wid = __builtin_amdgcn_readfirstlane(tid >> 6), lane = tid & 63, wr = wid >> 2, wc = wid & 3, fr = lane & 15, fq = lane >> 4;
    const int K = g.K, nt = K / BK;
    unsigned voffA[2], voffB[2];
#pragma unroll
    for (int i = 0; i < 2; ++i) { int R, C; stage_rc(tid * 16 + i * 8192, R, C); const int Rb = Epi::PERM ? ((R >> 5) * (g.kgrp == 2 ? 32 : 64) + perm32(R & 31)) : R;
        voffA[i] = g.kgrp == 3 ? (unsigned)((C >> 4) * (NTOK * 16) + R * 16 + (C & 15)) * 2u : (unsigned)(R * g.lda + C) * 2u; voffB[i] = (unsigned)(Rb * g.ldb + C) * 2u; }
    const size_t kstep = (size_t)(BK * 2), kstepA = g.kgrp == 3 ? (size_t)4 * NTOK * 16 * 2 : kstep;
    const size_t hstepA = (size_t)HALF * (g.kgrp == 3 ? 16 : g.lda) * 2, hstepB = (size_t)(Epi::PERM ? (g.kgrp == 2 ? 2048 : 32) : HALF) * g.ldb * 2;
    const unsigned ldsw = (unsigned)wid * 1024u;
    const int aoff = lds_byte(wr * 64 + fr, fq * 8), boff = lds_byte(wc * 32 + fr, fq * 8);
#define PG8_SA(b, h) (((b) * 2 + (h)) * HTB)
#define PG8_SB(b, h) ((4 + (b) * 2 + (h)) * HTB)
#define PG8_STAGE(bufoff, gbase, voff) do { _Pragma("unroll") for (int _i = 0; _i < 2; ++_i) \
        __builtin_amdgcn_global_load_lds((const unsigned*)((const char*)(gbase) + (voff)[_i]), (LAS unsigned*)(lds + (bufoff) + ldsw + _i * 8192), 16, 0, 0); } while (0)
#define PG8_LDA(dst, b, h) do { _Pragma("unroll") for (int m = 0; m < 4; ++m) _Pragma("unroll") for (int k = 0; k < 2; ++k) dst[m][k] = *(const LAS bf16x8*)(lds + PG8_SA(b, h) + aoff + m * 2048 + k * 1024); } while (0)
#define PG8_LDB(dst, b, h) do { _Pragma("unroll") for (int n = 0; n < 2; ++n) _Pragma("unroll") for (int k = 0; k < 2; ++k) dst[n][k] = *(const LAS bf16x8*)(lds + PG8_SB(b, h) + boff + n * 2048 + k * 1024); } while (0)
#define PG8_MMA(ai, bj, At, Bt) do { __builtin_amdgcn_s_setprio(1); _Pragma("unroll") for (int m = 0; m < 4; ++m) _Pragma("unroll") for (int n = 0; n < 2; ++n) _Pragma("unroll") for (int k = 0; k < 2; ++k) \
        acc[ai][bj][m][n] = __builtin_amdgcn_mfma_f32_16x16x32_bf16(Bt[n][k], At[m][k], acc[ai][bj][m][n], 0, 0, 0); __builtin_amdgcn_s_setprio(0); } while (0)
#define PG8_WAIT_V(n) asm volatile("s_waitcnt vmcnt(" #n ")" ::: "memory")
#define PG8_WAIT_L(n) asm volatile("s_waitcnt lgkmcnt(" #n ")" ::: "memory")
#define PG8_BAR __builtin_amdgcn_s_barrier()
#define PG8_SCHED __builtin_amdgcn_sched_barrier(0)
    Unit cur, nxt; int ui = 0;
    if (!S.next(0, cur)) return;
    f32x4 acc[2][2][4][2];
#pragma unroll
    for (int a = 0; a < 2; ++a)
#pragma unroll
        for (int b = 0; b < 2; ++b)
#pragma unroll
            for (int m = 0; m < 4; ++m)
#pragma unroll
                for (int n = 0; n < 2; ++n) acc[a][b][m][n] = (f32x4){0.f, 0.f, 0.f, 0.f};
    bf16x8 At[4][2], B0[2][2], B1[2][2];
    const char* cA = g.a_ptr(cur); const char* cB = g.b_ptr(cur);
    if constexpr (SP2) {
        PG8_STAGE(PG8_SB(0, 0), cB, voffB); PG8_STAGE(PG8_SB(0, 1), cB + hstepB, voffB); PG8_STAGE(PG8_SA(0, 0), cA, voffA); PG8_STAGE(PG8_SA(0, 1), cA + hstepA, voffA);
        PG8_STAGE(PG8_SB(1, 0), cB + kstep, voffB); PG8_STAGE(PG8_SA(1, 0), cA + kstepA, voffA); PG8_STAGE(PG8_SB(1, 1), cB + hstepB + kstep, voffB);
        if (wr == 1) PG8_BAR;
        PG8_WAIT_V(8); PG8_BAR;
        PG8_WAIT_V(6); PG8_BAR;
    } else {
    PG8_STAGE(PG8_SB(0, 0), cB, voffB); PG8_STAGE(PG8_SA(0, 0), cA, voffA); PG8_STAGE(PG8_SB(0, 1), cB + hstepB, voffB); PG8_STAGE(PG8_SA(0, 1), cA + hstepA, voffA);
    if (wr == 1) PG8_BAR;
    PG8_WAIT_V(4); PG8_BAR;
    PG8_STAGE(PG8_SB(1, 0), cB + kstep, voffB); PG8_STAGE(PG8_SA(1, 0), cA + kstepA, voffA); PG8_STAGE(PG8_SB(1, 1), cB + hstepB + kstep, voffB);
    PG8_WAIT_V(6); PG8_BAR;
    }
    for (;;) {
        const bool has_next = S.next(ui + 1, nxt);
        const char* nA = has_next ? g.a_ptr(nxt) : cA; const char* nB = has_next ? g.b_ptr(nxt) : cB;
        for (int t = 0; t < nt; t += 2) {
            const bool last = (t == nt - 2);
            const char* a1 = cA + (size_t)(t + 1) * kstepA;
            const char* a2 = last ? nA : cA + (size_t)(t + 2) * kstepA; const char* b2 = last ? nB : cB + (size_t)(t + 2) * kstep;
            const char* a3 = a2 + kstepA; const char* b3 = b2 + kstep;
            if constexpr (SP2) {
            PG8_LDB(B0, 0, 0); PG8_LDB(B1, 0, 1); PG8_SCHED; PG8_LDA(At, 0, 0); PG8_STAGE(PG8_SA(1, 1), a1 + hstepA, voffA);
            PG8_WAIT_V(8); PG8_WAIT_L(0); PG8_BAR; PG8_MMA(0, 0, At, B0); PG8_MMA(0, 1, At, B1); PG8_BAR; PG8_SCHED;
            PG8_LDA(At, 0, 1); PG8_STAGE(PG8_SB(0, 0), b2, voffB); PG8_STAGE(PG8_SB(0, 1), b2 + hstepB, voffB); PG8_STAGE(PG8_SA(0, 0), a2, voffA);
            PG8_WAIT_V(8); PG8_WAIT_L(0); PG8_BAR; PG8_MMA(1, 0, At, B0); PG8_MMA(1, 1, At, B1); PG8_BAR; PG8_SCHED;
            PG8_LDB(B0, 1, 0); PG8_LDB(B1, 1, 1); PG8_SCHED; PG8_LDA(At, 1, 0); PG8_STAGE(PG8_SA(0, 1), a2 + hstepA, voffA);
            PG8_WAIT_V(8); PG8_WAIT_L(0); PG8_BAR; PG8_MMA(0, 0, At, B0); PG8_MMA(0, 1, At, B1); PG8_BAR; PG8_SCHED;
            PG8_LDA(At, 1, 1); PG8_STAGE(PG8_SB(1, 0), b3, voffB); PG8_STAGE(PG8_SB(1, 1), b3 + hstepB, voffB); PG8_STAGE(PG8_SA(1, 0), a3, voffA);
            PG8_WAIT_V(8); PG8_WAIT_L(0); PG8_BAR; PG8_MMA(1, 0, At, B0); PG8_MMA(1, 1, At, B1); PG8_BAR; PG8_SCHED;
            } else {
            PG8_LDB(B0, 0, 0); PG8_SCHED; PG8_LDA(At, 0, 0); PG8_STAGE(PG8_SA(1, 1), a1 + hstepA, voffA);
            PG8_WAIT_L(8); PG8_BAR; PG8_WAIT_L(0); PG8_MMA(0, 0, At, B0); PG8_BAR; PG8_SCHED;
            PG8_LDB(B1, 0, 1); PG8_STAGE(PG8_SB(0, 0), b2, voffB);
            PG8_BAR; PG8_WAIT_L(0); PG8_MMA(0, 1, At, B1); PG8_BAR;
            PG8_LDA(At, 0, 1); PG8_STAGE(PG8_SA(0, 0), a2, voffA);
            PG8_BAR; PG8_WAIT_L(0); PG8_MMA(1, 0, At, B0); PG8_BAR; PG8_SCHED;
            PG8_STAGE(PG8_SB(0, 1), b2 + hstepB, voffB);
            PG8_WAIT_V(6); PG8_BAR; PG8_MMA(1, 1, At, B1); PG8_BAR;
            PG8_LDB(B0, 1, 0); PG8_SCHED; PG8_LDA(At, 1, 0); PG8_STAGE(PG8_SA(0, 1), a2 + hstepA, voffA);
            PG8_WAIT_L(8); PG8_BAR; PG8_WAIT_L(0); PG8_MMA(0, 0, At, B0); PG8_BAR; PG8_SCHED;
            PG8_LDB(B1, 1, 1); PG8_STAGE(PG8_SB(1, 0), b3, voffB);
            PG8_BAR; PG8_WAIT_L(0); PG8_MMA(0, 1, At, B1); PG8_BAR;
            PG8_LDA(At, 1, 1); PG8_STAGE(PG8_SA(1, 0), a3, voffA);
            PG8_BAR; PG8_WAIT_L(0); PG8_MMA(1, 0, At, B0); PG8_BAR; PG8_SCHED;
            PG8_STAGE(PG8_SB(1, 1), b3 + hstepB, voffB);
            PG8_WAIT_V(6); PG8_BAR; PG8_MMA(1, 1, At, B1); PG8_BAR;
            }
        }
        if constexpr (ALIGN_EPI) { if (wr == 0) PG8_BAR; }
        E(acc, cur, wr, wc, fr, fq);
        if (!has_next) break;
#pragma unroll
        for (int a = 0; a < 2; ++a)
#pragma unroll
            for (int b = 0; b < 2; ++b)
#pragma unroll
                for (int m = 0; m < 4; ++m)
#pragma unroll
                    for (int n = 0; n < 2; ++n) acc[a][b][m][n] = (f32x4){0.f, 0.f, 0.f, 0.f};
        cur = nxt; cA = nA; cB = nB; ++ui;
        if constexpr (ALIGN_EPI) { if (wr == 1) PG8_BAR; }
    }
    PG8_WAIT_V(0);
    if constexpr (!ALIGN_EPI) { if (wr == 0) PG8_BAR; }
    PG8_BAR;
#undef PG8_SA
#undef PG8_SB
#undef PG8_STAGE
#undef PG8_LDA
#undef PG8_LDB
#undef PG8_MMA
#undef PG8_WAIT_V
#undef PG8_WAIT_L
#undef PG8_BAR
#undef PG8_SCHED
}
}

__device__ __forceinline__ void rms_phase_b(const int tid, const bf16_t* x, const float* w, bf16_t* outp) {
    const int wid = tid >> 6, lane = tid & 63;
    for (int row = blockIdx.x * 8 + wid; row < NTOK; row += gridDim.x * 8) {
        const bf16_t* xr = x + (size_t)row * DM;
        float v[4][8];
#pragma unroll
        for (int j = 0; j < 4; ++j) unpack8(*(const u32x4*)(xr + j * 512 + lane * 8), v[j]);
        float ss = 0.f;
#pragma unroll
        for (int j = 0; j < 4; ++j)
#pragma unroll
            for (int q = 0; q < 8; ++q) ss += v[j][q] * v[j][q];
#pragma unroll
        for (int o = 32; o >= 1; o >>= 1) ss += __shfl_xor(ss, o);
        const float r = 1.0f / sqrtf(ss * (1.0f / DM) + 1e-6f);
#pragma unroll
        for (int j = 0; j < 4; ++j) {
            const f32x4 w0 = *(const f32x4*)(w + j * 512 + lane * 8), w1 = *(const f32x4*)(w + j * 512 + lane * 8 + 4);
            float o[8];
#pragma unroll
            for (int q = 0; q < 4; ++q) { o[q] = v[j][q] * r * w0[q]; o[4 + q] = v[j][4 + q] * r * w1[q]; }
            *(u32x4*)(outp + (size_t)row * DM + j * 512 + lane * 8) = pack8(o);
        }
    }
}

template <bool TOBF>
__device__ __forceinline__ void rms_phase(const int tid, const float* x0, const float* x1, const float* w, void* outp) {
    const int wid = tid >> 6, lane = tid & 63;
    f32x4 v[8], vn[8];
    int row = blockIdx.x * 8 + wid;
    if (row < NTOK) { const float* xr = (row < SEQL ? x0 : x1) + (size_t)row * DM;
#pragma unroll
        for (int j = 0; j < 4; ++j) { v[2 * j] = *(const f32x4*)(xr + j * 512 + lane * 8); v[2 * j + 1] = *(const f32x4*)(xr + j * 512 + lane * 8 + 4); } }
    for (; row < NTOK; row += gridDim.x * 8) {
        const int nrow = row + gridDim.x * 8;
        if (nrow < NTOK) { const float* xn = (nrow < SEQL ? x0 : x1) + (size_t)nrow * DM;
#pragma unroll
            for (int j = 0; j < 4; ++j) { vn[2 * j] = *(const f32x4*)(xn + j * 512 + lane * 8); vn[2 * j + 1] = *(const f32x4*)(xn + j * 512 + lane * 8 + 4); } }
        float ss = 0.f;
#pragma unroll
        for (int j = 0; j < 8; ++j) ss += v[j][0] * v[j][0] + v[j][1] * v[j][1] + v[j][2] * v[j][2] + v[j][3] * v[j][3];
#pragma unroll
        for (int o = 32; o >= 1; o >>= 1) ss += __shfl_xor(ss, o);
        const float r = 1.0f / sqrtf(ss * (1.0f / DM) + 1e-6f);
#pragma unroll
        for (int j = 0; j < 4; ++j) {
            const f32x4 w0 = *(const f32x4*)(w + j * 512 + lane * 8), w1 = *(const f32x4*)(w + j * 512 + lane * 8 + 4);
            const f32x4 a = v[2 * j] * r * w0, b = v[2 * j + 1] * r * w1;
            if (TOBF) { u32x4 p; p.x = pk_bf16(a[0], a[1]); p.y = pk_bf16(a[2], a[3]); p.z = pk_bf16(b[0], b[1]); p.w = pk_bf16(b[2], b[3]);
                *(u32x4*)((bf16_t*)outp + (size_t)row * DM + j * 512 + lane * 8) = p; }
            else { float* o = (float*)outp + (size_t)row * DM + j * 512 + lane * 8; *(f32x4*)o = a; *(f32x4*)(o + 4) = b; }
        }
#pragma unroll
        for (int j = 0; j < 8; ++j) v[j] = vn[j];
    }
}

__device__ __forceinline__ void poole_phase(const int tid, const bf16_t* UB, bf16_t* Pp, LAS unsigned char* lds) {
    const int o = tid & 63, w8 = tid >> 6;
    u32x4 v[10];
    int item = blockIdx.x; asm volatile("" : "+s"(item));
#define POOLE_LOAD(item_) do { const int t0_ = ((item_) >> 2) * 64, tl0_ = t0_ & (SEQL - 1), cg_ = (item_) & 3; const size_t sb_ = (size_t)(t0_ - tl0_); \
        _Pragma("unroll") for (int k = 0; k < 10; ++k) { const int tl = tl0_ - 8 + w8 + 8 * k; v[k] = (u32x4){0u, 0u, 0u, 0u}; \
            if (tl >= 0 && tl < SEQL) v[k] = *(const u32x4*)(UB + (sb_ + tl) * DM + cg_ * 512 + o * 8); } } while (0)
    if (item < (NTOK / 64) * 4) POOLE_LOAD(item);
    while (item < (NTOK / 64) * 4) {
        const int tt = item >> 2, cg = item & 3, t0 = tt * 64, tl0 = t0 & (SEQL - 1), half = 1 << cg;
        const size_t seqbase = (size_t)(t0 - tl0);
#pragma unroll
        for (int k = 0; k < 10; ++k) *(LAS u32x4*)(lds + ((w8 + 8 * k) * 64 + o) * 16) = v[k];
        __syncthreads();
        item += gridDim.x;
        if (item < (NTOK / 64) * 4) POOLE_LOAD(item);
        { const int first = tl0 + w8 * 8; float sum[8];
#pragma unroll
          for (int j = 0; j < 8; ++j) sum[j] = 0.f;
          for (int s_ = first - half; s_ < first + half; ++s_) { float u[8]; unpack8(*(const LAS u32x4*)(lds + ((s_ - tl0 + 8) * 64 + o) * 16), u);
#pragma unroll
              for (int j = 0; j < 8; ++j) sum[j] += u[j]; }
#pragma unroll
          for (int q = 0; q < 8; ++q) { const int t = first + q, lo = t - half < 0 ? 0 : t - half, hi = t + half > SEQL ? SEQL : t + half; const float ic = 1.0f / (float)(hi - lo);
              float u[8], ov[8], a[8], b[8]; unpack8(*(const LAS u32x4*)(lds + ((t - tl0 + 8) * 64 + o) * 16), u);
#pragma unroll
              for (int j = 0; j < 8; ++j) ov[j] = sum[j] * ic - u[j];
              *(u32x4*)(Pp + (seqbase + t) * DM + cg * 512 + o * 8) = pack8(ov);
              unpack8(*(const LAS u32x4*)(lds + ((t + half - tl0 + 8) * 64 + o) * 16), a); unpack8(*(const LAS u32x4*)(lds + ((t - half - tl0 + 8) * 64 + o) * 16), b);
#pragma unroll
              for (int j = 0; j < 8; ++j) sum[j] += a[j] - b[j]; } }
        __syncthreads();
    }
#undef POOLE_LOAD
}

__device__ __forceinline__ void carry_wave(const Params& P, int l, const float* E, bf16_t* Ug, int g, int sq, int dir, int lane) {
    const int pi = ((l * 2 + dir) * SGRP + g) * 64 + lane;
    const float lr = fminf(P.lam_re[pi], -1e-4f), li = P.lam_im[pi], dt = expf(P.log_dt[(l * 2 + dir) * SGRP + g]);
    float ar, ai; lam_pow(lr, li, dt, TCH, ar, ai);
    float hr = 0.f, hi = 0.f;
    const float* Eb = E + ((size_t)g * UROWS + sq * NCHK) * 256 + dir * 128 + lane;
    bf16_t* Hb = Ug + ((size_t)g * UROWS + sq * NCHK) * UKK + 512 + dir * 128 + lane;
    for (int k0 = 0; k0 < NCHK; k0 += 32) {
        float er[32], ei[32];
#pragma unroll
        for (int j = 0; j < 32; ++j) { const int k = dir ? (NCHK - 1 - k0 - j) : (k0 + j); er[j] = Eb[(size_t)k * 256]; ei[j] = Eb[(size_t)k * 256 + 64]; }
#pragma unroll
        for (int j = 0; j < 32; ++j) { const int k = dir ? (NCHK - 1 - k0 - j) : (k0 + j);
            Hb[(size_t)k * UKK] = (bf16_t)(pk_bf16(hr, 0.f) & 0xffffu); Hb[(size_t)k * UKK + 64] = (bf16_t)(pk_bf16(hi, 0.f) & 0xffffu);
            const float nr = ar * hr - ai * hi + er[j], ni = ar * hi + ai * hr + ei[j]; hr = nr; hi = ni; }
    }
}

__device__ __forceinline__ void prep_phase(const int tid, unsigned char* ws, const Params& P, int l, LAS unsigned char* lds) {
    LAS float* LP = (LAS float*)lds;
    LAS float* BB = LP + 8448;
    LAS float* KT = BB + 4096;
    LAS float* CC = KT + 16128;
    bf16_t* Mg = (bf16_t*)(ws + OFF_MG); bf16_t* Bt = (bf16_t*)(ws + OFF_BT);
    const int nS = (int)gridDim.x < SGRP ? (int)gridDim.x : SGRP;
    for (int g = blockIdx.x; g < SGRP && (int)blockIdx.x < nS; g += nS) {
        if (tid < 128) {
            const int d = tid >> 6, p = tid & 63;
            const int pi = ((l * 2 + d) * SGRP + g) * 64 + p;
            const float lr = fminf(P.lam_re[pi], -1e-4f), li = P.lam_im[pi], dt = expf(P.log_dt[(l * 2 + d) * SGRP + g]);
            float ar, ai; lam_pow(lr, li, dt, 1, ar, ai);
            float re = 1.f, im = 0.f; LAS float* lp = LP + (d * 64 + p) * 33 * 2;
            for (int n = 0; n <= 32; ++n) { lp[n * 2] = re; lp[n * 2 + 1] = im; const float nr = re * ar - im * ai, ni = re * ai + im * ar; re = nr; im = ni; }
        }
        __syncthreads();
        for (int idx = tid; idx < 2048; idx += NTHREADS) {
            const int d = idx >> 10, p = (idx >> 4) & 63, c = idx & 15;
            const int pi = ((l * 2 + d) * SGRP + g) * 64 + p;
            const float lr = fminf(P.lam_re[pi], -1e-4f), li = P.lam_im[pi];
            const float ar = LP[((d * 64 + p) * 33 + 1) * 2], ai = LP[((d * 64 + p) * 33 + 1) * 2 + 1];
            const float den = lr * lr + li * li, nr = ((ar - 1.0f) * lr + ai * li) / den, ni = (ai * lr - (ar - 1.0f) * li) / den;
            const float br = P.b_re[(size_t)pi * 16 + c], bi = P.b_im[(size_t)pi * 16 + c];
            BB[idx] = nr * br - ni * bi; BB[2048 + idx] = nr * bi + ni * br;
            const size_t ci = ((size_t)((l * 2 + d) * SGRP + g) * 16 + c) * 64 + p;
            CC[((d * 16 + c) * 64 + p) * 2] = P.c_re[ci]; CC[((d * 16 + c) * 64 + p) * 2 + 1] = P.c_im[ci];
        }
        __syncthreads();
        for (int it = tid; it < 63 * 16; it += NTHREADS) {
            const int ti = it >> 4, cb = ((it >> 2) & 3) * 4, c2b = (it & 3) * 4, tau = ti - 31, n = tau < 0 ? -tau : tau;
            f32x2_t sacc[4][2];
#pragma unroll
            for (int i = 0; i < 4; ++i) { sacc[i][0] = (f32x2_t){0.f, 0.f}; sacc[i][1] = (f32x2_t){0.f, 0.f}; }
            for (int d = 0; d < 2; ++d) {
                if (d == 0 ? (tau < 0) : (tau > 0)) continue;
                for (int p = 0; p < 64; ++p) {
                    const f32x2_t lam = *(const LAS f32x2_t*)(LP + ((d * 64 + p) * 33 + n) * 2);
                    const f32x4 brv = *(const LAS f32x4*)(BB + (d * 64 + p) * 16 + c2b), biv = *(const LAS f32x4*)(BB + 2048 + (d * 64 + p) * 16 + c2b);
                    const f32x2_t br0 = {brv[0], brv[1]}, br1 = {brv[2], brv[3]}, bi0 = {biv[0], biv[1]}, bi1 = {biv[2], biv[3]};
#pragma unroll
                    for (int i = 0; i < 4; ++i) {
                        const f32x2_t cc = *(const LAS f32x2_t*)(CC + ((d * 16 + cb + i) * 64 + p) * 2);
                        const float xr = cc[0] * lam[0] - cc[1] * lam[1], xi = cc[0] * lam[1] + cc[1] * lam[0];
                        const f32x2_t xr2 = {xr, xr}, xi2 = {-xi, -xi};
                        sacc[i][0] = __builtin_elementwise_fma(xr2, br0, sacc[i][0]); sacc[i][0] = __builtin_elementwise_fma(xi2, bi0, sacc[i][0]);
                        sacc[i][1] = __builtin_elementwise_fma(xr2, br1, sacc[i][1]); sacc[i][1] = __builtin_elementwise_fma(xi2, bi1, sacc[i][1]);
                    }
                }
            }
#pragma unroll
            for (int i = 0; i < 4; ++i) { LAS float* kp = KT + (ti * 16 + cb + i) * 16 + c2b; kp[0] = sacc[i][0][0]; kp[1] = sacc[i][0][1]; kp[2] = sacc[i][1][0]; kp[3] = sacc[i][1][1]; }
        }
        __syncthreads();
        for (int it = tid; it < 512 * 96; it += NTHREADS) {
            const int rl = it / 96, oc = it % 96, nrow = rl, t = nrow >> 4, c = nrow & 15, k0 = oc * 8;
            float v[8];
            if (k0 < 512) {
                const int s = k0 >> 4, c0 = k0 & 15, tau = t - s;
                const float dsk = P.ssm_d[l * DM + g * 16 + c];
#pragma unroll
                for (int q = 0; q < 8; ++q) v[q] = KT[((tau + 31) * 16 + c) * 16 + c0 + q] + ((tau == 0 && c == c0 + q) ? dsk : 0.f);
            } else {
                const int j0 = k0 - 512, d = j0 >> 7, part = (j0 >> 6) & 1, p0 = j0 & 63, e = d ? (TCH - t) : (t + 1);
#pragma unroll
                for (int q = 0; q < 8; ++q) { const int p = p0 + q;
                    const float cr = CC[((d * 16 + c) * 64 + p) * 2], ci = CC[((d * 16 + c) * 64 + p) * 2 + 1];
                    const float lr = LP[((d * 64 + p) * 33 + e) * 2], li = LP[((d * 64 + p) * 33 + e) * 2 + 1];
                    v[q] = part ? -(cr * li + ci * lr) : (cr * lr - ci * li); }
            }
            *(u32x4*)(Mg + ((size_t)g * 512 + nrow) * UKK + k0) = pack8(v);
        }
        for (int it = tid; it < 256 * 64; it += NTHREADS) {
            const int rl = it >> 6, oc = it & 63, d = rl >> 7, part = (rl >> 6) & 1, p = rl & 63, k0 = oc * 8, s = k0 >> 4, c0 = k0 & 15, e = d ? s : (TCH - 1 - s);
            const float lr = LP[((d * 64 + p) * 33 + e) * 2], li = LP[((d * 64 + p) * 33 + e) * 2 + 1];
            float v[8];
#pragma unroll
            for (int q = 0; q < 8; ++q) { const float br = BB[(d * 64 + p) * 16 + c0 + q], bi = BB[2048 + (d * 64 + p) * 16 + c0 + q];
                v[q] = part ? (lr * bi + li * br) : (lr * br - li * bi); }
            *(u32x4*)(Bt + ((size_t)g * 256 + rl) * 512 + k0) = pack8(v);
        }
        __syncthreads();
    }
    LAS float* tile = (LAS float*)lds;
    const int kr = tid >> 6, nc = (tid & 63) * 4, nr = tid >> 1, ko = (tid & 1) * 32;
#define TR_DECODE(t_, src_, dst_, K_, N_, k0_, n0_) do { int tk_, tn_; \
        if ((t_) < 1536) { src_ = P.w_in + (size_t)l * DM * INC; dst_ = (bf16_t*)(ws + OFF_WINT); K_ = DM; N_ = INC; tk_ = (t_) / 48; tn_ = (t_) % 48; } \
        else if ((t_) < 2560) { const int q = (t_) - 1536, mi = q >> 8, r = q & 255; tk_ = r >> 3; tn_ = r & 7; K_ = DM; N_ = DM; \
            src_ = (mi == 0 ? P.glu_w : mi == 1 ? P.proj_a : mi == 2 ? P.proj_b : P.w_out) + (size_t)l * DM * DM; \
            dst_ = (bf16_t*)(ws + (mi == 0 ? OFF_GLUT : mi == 1 ? OFF_PAT : mi == 2 ? OFF_PBT : OFF_WOT)); } \
        else { const int q = (t_) - 2560, gi = q >> 4, r = q & 15; tk_ = r >> 1; tn_ = r & 1; K_ = 512; N_ = 512; \
            src_ = P.pool_w + (size_t)(l * 4 + gi) * 512 * 512; dst_ = (bf16_t*)(ws + OFF_POOLT) + (size_t)gi * 512 * 512; } \
        k0_ = tk_ * 64; n0_ = tn_ * 256; } while (0)
    constexpr int TSPLIT = 2368;
    const bool s5blk = (int)blockIdx.x < nS, two = (int)gridDim.x > nS;
    int t_end = two ? (s5blk ? 2624 : TSPLIT) : 2624, t_step = two ? (s5blk ? nS : (int)gridDim.x - nS) : (int)gridDim.x;
    f32x4 v[8];
    int t = two ? (s5blk ? TSPLIT + (int)blockIdx.x : (int)blockIdx.x - nS) : (int)blockIdx.x;
    asm volatile("" : "+s"(t), "+s"(t_end), "+s"(t_step));
    const float* src; bf16_t* dst; int K, N, k0, n0;
    if (t < t_end) { TR_DECODE(t, src, dst, K, N, k0, n0);
#pragma unroll
        for (int i = 0; i < 8; ++i) v[i] = *(const f32x4*)(src + (size_t)(k0 + kr + 8 * i) * N + n0 + nc); }
    while (t < t_end) {
#pragma unroll
        for (int i = 0; i < 8; ++i) *(LAS f32x4*)(tile + (kr + 8 * i) * 260 + nc) = v[i];
        __syncthreads();
        bf16_t* cdst = dst; const int cK = K, ck0 = k0, cn0 = n0;
        t += t_step;
        if (t < t_end) { TR_DECODE(t, src, dst, K, N, k0, n0);
#pragma unroll
            for (int i = 0; i < 8; ++i) v[i] = *(const f32x4*)(src + (size_t)(k0 + kr + 8 * i) * N + n0 + nc); }
#pragma unroll
        for (int q4 = 0; q4 < 4; ++q4) { float o[8];
#pragma unroll
            for (int q = 0; q < 8; ++q) o[q] = tile[(ko + q4 * 8 + q) * 260 + nr];
            *(u32x4*)(cdst + (size_t)(cn0 + nr) * cK + ck0 + ko + q4 * 8) = pack8(o); }
        __syncthreads();
    }
#undef TR_DECODE
}

constexpr int PH_PER_LAYER = 13, N_PHASES = 2 * PH_PER_LAYER + 1;

__device__ __forceinline__ void run_phase(const Params& P, int ph, LAS unsigned char* lds) {
    int tid = threadIdx.x; asm volatile("" : "+v"(tid));
    int c = blockIdx.x; asm volatile("" : "+s"(c));
    size_t zoff = 0; asm volatile("" : "+s"(zoff));
    unsigned char* ws = P.ws + zoff;
    bf16_t* WinT = (bf16_t*)(ws + OFF_WINT); bf16_t* GluT = (bf16_t*)(ws + OFF_GLUT); bf16_t* PaT = (bf16_t*)(ws + OFF_PAT); bf16_t* PbT = (bf16_t*)(ws + OFF_PBT);
    bf16_t* WoT = (bf16_t*)(ws + OFF_WOT); bf16_t* PoolT = (bf16_t*)(ws + OFF_POOLT); bf16_t* Mg = (bf16_t*)(ws + OFF_MG); bf16_t* Bt = (bf16_t*)(ws + OFF_BT);
    bf16_t* H = (bf16_t*)(ws + OFF_H); bf16_t* Ug = (bf16_t*)(ws + OFF_RA); bf16_t* UB = (bf16_t*)(ws + OFF_RA); bf16_t* SGA = (bf16_t*)(ws + OFF_RA);
    bf16_t* SZA = (bf16_t*)(ws + OFF_RB); float* Ebuf = (float*)(ws + OFF_RC); bf16_t* YS5 = (bf16_t*)(ws + OFF_RC); bf16_t* PP = (bf16_t*)(ws + OFF_RC); bf16_t* SGB = (bf16_t*)(ws + OFF_RC);
    bf16_t* SZB = (bf16_t*)(ws + OFF_RD);
    const int G = gridDim.x;
    bf16_t* X1B = (bf16_t*)P.out;
    float* X2 = (float*)(ws + OFF_RB);
    if (ph == 2 * PH_PER_LAYER) { rms_phase<false>(tid, X2, X2, P.final_norm_w, P.out); return; }
    const int l = ph / PH_PER_LAYER, sp = ph % PH_PER_LAYER;
    const float* xin0 = P.x_prompt;
    const float* xin1 = P.x_sample - (size_t)SEQL * DM;
    switch (sp) {
    case 0: prep_phase(tid, ws, P, l, lds); if (l == 0) rms_phase<true>(tid, xin0, xin1, P.norm_w, H); else rms_phase_b(tid, X1B, P.norm_w + DM, H); break;
    case 1: { pg8::Gemm g{H, WinT, DM, DM, DM, 0, 0, 0}; pg8::StaticOrder S; S.init(NTOK, 4096, G, c); S.rev = sp & 1;
        pg8::EpiB<pg8::E_G1A> E{Ug, SZA, nullptr, nullptr}; pg8::gemm_phase(lds, tid, g, S, E); } break;
    case 2: { pg8::Gemm g{Ug, Bt, UKK, 512, 512, 0, (size_t)UROWS * UKK, (size_t)256 * 512}; pg8::BatchOrder S; S.init(SGRP, 3, 1, G, c); S.rev = sp & 1;
        pg8::EpiF<pg8::F_S5P1> E{Ebuf, nullptr, nullptr}; pg8::gemm_phase(lds, tid, g, S, E); } break;
    case 3: {
        asm volatile("s_waitcnt vmcnt(0)" ::: "memory"); __syncthreads();
        __builtin_amdgcn_fence(__ATOMIC_ACQUIRE, "agent"); asm volatile("s_waitcnt vmcnt(0)" ::: "memory");
        pg8::BatchOrder S; S.init(SGRP, 3, 1, G, c); S.rev = 0;
        const int w = tid >> 6; pg8::Unit u; if (w < 4 && S.next(w >> 1, u)) carry_wave(P, l, Ebuf, Ug, u.b, u.pm, w & 1, tid & 63); } break;
    case 4: { pg8::Gemm g{Ug, Mg, UKK, UKK, UKK, 0, (size_t)UROWS * UKK, (size_t)512 * UKK}; pg8::BatchOrder S; S.init(SGRP, 3, 2, G, c); S.rev = sp & 1;
        pg8::EpiB<pg8::E_S5P2> E{YS5, nullptr, nullptr, nullptr}; pg8::gemm_phase(lds, tid, g, S, E); } break;
    case 5: { pg8::Gemm g{YS5, GluT, DM, DM, DM, 3, 0, 0}; pg8::StaticOrder S; S.init(NTOK, DM, G, c); S.rev = sp & 1;
        pg8::EpiB<pg8::E_GLU> E{SZA, nullptr, YS5, P.glu_b + l * DM}; pg8::gemm_phase(lds, tid, g, S, E); } break;
    case 6: { pg8::Gemm g{H, WinT + (size_t)4096 * DM, DM, DM, DM, 0, 0, 0}; pg8::StaticOrder S; S.init(NTOK, 4096, G, c); S.rev = sp & 1;
        pg8::EpiB<pg8::E_G1B> E{UB, SZB, nullptr, nullptr}; pg8::gemm_phase(lds, tid, g, S, E); } break;
    case 7: poole_phase(tid, UB, PP, lds); break;
    case 8: { pg8::Gemm g{PP, PoolT, DM, 512, 512, 1, 0, 0}; pg8::StaticOrder S; S.init(NTOK, DM, G, c); S.rev = 1;
        pg8::EpiB<pg8::E_POOL> E{SZB, nullptr, nullptr, P.pool_scale + l * DM}; pg8::gemm_phase(lds, tid, g, S, E); } break;
    case 9: { pg8::Gemm g{SZA, PaT, DM, DM, DM, 0, 0, 0}; pg8::StaticOrder S; S.init(NTOK, DM, G, c); S.rev = 0;
        pg8::EpiB<pg8::E_RAW> E{SGA, nullptr, nullptr, nullptr}; pg8::gemm_phase(lds, tid, g, S, E); } break;
    case 10: { pg8::Gemm g{SZB, PbT, DM, DM, DM, 0, 0, 0}; pg8::StaticOrder S; S.init(NTOK, DM, G, c); S.rev = 0;
        pg8::EpiB<pg8::E_RAW> E{SGB, nullptr, nullptr, nullptr}; pg8::gemm_phase(lds, tid, g, S, E); } break;
    case 11: { pg8::Gemm g{H, WinT + (size_t)8192 * DM, DM, DM, DM, 2, 0, 0}; pg8::StaticOrder S; S.init(NTOK, 4096, G, c); S.rev = 1;
        pg8::EpiB<pg8::E_MERGE> E{SGA, nullptr, SGB, P.gate_b + l * 2 * DM}; pg8::gemm_phase(lds, tid, g, S, E); } break;
    case 12: { pg8::Gemm g{SGA, WoT, DM, DM, DM, 0, 0, 0}; pg8::StaticOrder S; S.init(NTOK, DM, G, c); S.rev = 0;
        if (l == 0) { pg8::EpiB<pg8::E_RES0> E{X1B, nullptr, nullptr, xin0, xin1, nullptr}; pg8::gemm_phase(lds, tid, g, S, E); }
        else { pg8::EpiB<pg8::E_RES1> E{nullptr, nullptr, X1B, nullptr, nullptr, X2}; pg8::gemm_phase(lds, tid, g, S, E); } } break;
    }
}


#define XB_TMO      128
#define XB_XCNT(j)  (256  + 64 * (j))
#define XB_XSUB(j)  (1280 + 64 * (j))
#define XB_XGEN(j)  (2304 + 64 * (j))
#define XB_TOP      3328
#define XB_TOPGEN   3392
#define XCD_BAR_WORDS 3456
#define XB_SPIN_CAP (1u << 18)
__device__ __forceinline__ unsigned xb_ld(unsigned* p)              { return __hip_atomic_load(p, __ATOMIC_RELAXED, __HIP_MEMORY_SCOPE_AGENT); }
__device__ __forceinline__ unsigned xb_add(unsigned* p, unsigned v) { return __hip_atomic_fetch_add(p, v, __ATOMIC_RELAXED, __HIP_MEMORY_SCOPE_AGENT); }
__device__ __forceinline__ unsigned xb_xcc_id() { return (unsigned)__builtin_amdgcn_s_getreg((3 << 11) | 20) & 0xFu; }
#define XB_SPIN(cond, bar) do { unsigned _sp = 0; while (cond) { __builtin_amdgcn_s_sleep(1); \
    if ((++_sp & 255u) == 0u) { if (xb_ld(&(bar)[XB_TMO])) break; if (_sp > XB_SPIN_CAP) { atomicAdd(&(bar)[XB_TMO], 1u); break; } } } } while (0)
struct XcdBarrier { unsigned* bar; unsigned x; volatile LAS unsigned* st; };
__device__ __forceinline__ XcdBarrier xcd_barrier_post(unsigned* bar, volatile LAS unsigned* st) {
    XcdBarrier b; b.bar = bar; b.x = xb_xcc_id(); b.st = st;
    if (threadIdx.x == 0) (void)xb_add(&bar[XB_XCNT(b.x)], 1u);
    return b;
}
__device__ __forceinline__ void xcd_barrier_complete(unsigned* bar, unsigned x, unsigned& nloc, unsigned& nx) {
    const unsigned G = gridDim.x * gridDim.y * gridDim.z;
    unsigned sum, cnt, mine, sp = 0u;
    for (;;) {
        sum = 0u; cnt = 0u; mine = 0u;
#pragma unroll
        for (unsigned j = 0; j < 16; ++j) { const unsigned c = xb_ld(&bar[XB_XCNT(j)]); sum += c; cnt += (c > 0u) ? 1u : 0u; mine = (j == x) ? c : mine; }
        if (sum == G) break;
        __builtin_amdgcn_s_sleep(1);
        if ((++sp & 255u) == 0u) { if (xb_ld(&bar[XB_TMO])) break; if (sp > XB_SPIN_CAP) { atomicAdd(&bar[XB_TMO], 1u); break; } }
    }
    nloc = mine > 0u ? mine : 1u; nx = cnt > 0u ? cnt : 1u;
}
__device__ __forceinline__ void xcd_barrier(const XcdBarrier& b) {
    asm volatile("s_waitcnt vmcnt(0)" ::: "memory");
    __syncthreads();
    if (threadIdx.x == 0) {
        unsigned* bar = b.bar;
        __builtin_amdgcn_s_waitcnt(0);
        unsigned nloc = b.st[0], nx = b.st[1];
        if (nloc == 0u) { xcd_barrier_complete(bar, b.x, nloc, nx); b.st[0] = nloc; b.st[1] = nx; }
        const unsigned old = xb_add(&bar[XB_XSUB(b.x)], 1u);
        const unsigned gen = old / nloc;
        if (old + 1u == (gen + 1u) * nloc) {
            __builtin_amdgcn_fence(__ATOMIC_RELEASE, "agent");
            asm volatile("s_waitcnt vmcnt(0)" ::: "memory");
            const unsigned og = xb_add(&bar[XB_TOP], 1u);
            const unsigned tg = og / nx;
            if (og + 1u == (tg + 1u) * nx) xb_add(&bar[XB_TOPGEN], 1u);
            else XB_SPIN(xb_ld(&bar[XB_TOPGEN]) == tg, bar);
            __builtin_amdgcn_fence(__ATOMIC_ACQUIRE, "agent");
            xb_add(&bar[XB_XGEN(b.x)], 1u);
            asm volatile("s_waitcnt vmcnt(0)" ::: "memory");
        } else {
            XB_SPIN(xb_ld(&bar[XB_XGEN(b.x)]) == gen, bar);
            __builtin_amdgcn_fence(__ATOMIC_ACQUIRE, "agent");
            asm volatile("s_waitcnt vmcnt(0)" ::: "memory");
        }
    }
    __syncthreads();
}
constexpr size_t OFF_BAR = 740 * MiB;

__global__ void __launch_bounds__(NTHREADS, 2) mega(Params P) {
    extern __shared__ __attribute__((aligned(16))) unsigned char lds_raw[];
    LAS unsigned char* lds = (LAS unsigned char*)lds_raw;
    cg::grid_group grid = cg::this_grid();
    volatile LAS unsigned* st = (volatile LAS unsigned*)(lds + 131072);
    if (threadIdx.x == 0) { st[0] = 0u; st[1] = 0u; }
    __syncthreads();
    XcdBarrier xb = xcd_barrier_post((unsigned*)(P.ws + OFF_BAR), st);
    for (int ph = P.ph_lo; ph < P.ph_hi; ++ph) {
        run_phase(P, ph, lds);
        const int spn = ph % PH_PER_LAYER;
        const bool local_seam = ph < 2 * PH_PER_LAYER && (spn == 2 || spn == 5 || spn == 8);
        if (ph + 1 < P.ph_hi && !local_seam) { if (P.ph_lo < 0) grid.sync(); else xcd_barrier(xb); }
    }
}

extern "C" void kernel_launch(void* const* d_in, const int* in_sizes, int n_in, void* d_out, int out_size, void* d_ws, size_t ws_size, hipStream_t stream) {
    static int grid_blocks = 0;
    if (!grid_blocks) {
        if (n_in != 21 || ws_size < OFF_BAR + XCD_BAR_WORDS * 4) { fprintf(stderr, "kernel_launch: unexpected n_in %d or ws_size %zu (< %zu)\n", n_in, ws_size, (size_t)WS_END); grid_blocks = -1; return; }
        int dev = 0, cus = 0, per_cu = 0;
        hipGetDevice(&dev);
        hipDeviceGetAttribute(&cus, hipDeviceAttributeMultiprocessorCount, dev);
        if (hipFuncSetAttribute((const void*)mega, hipFuncAttributeMaxDynamicSharedMemorySize, LDS_BYTES) != hipSuccess) { fprintf(stderr, "kernel_launch: hipFuncSetAttribute failed\n"); grid_blocks = -1; return; }
        if (hipOccupancyMaxActiveBlocksPerMultiprocessor(&per_cu, (const void*)mega, NTHREADS, LDS_BYTES) != hipSuccess || per_cu < 1) { fprintf(stderr, "kernel_launch: occupancy query gave %d\n", per_cu); per_cu = 1; }
        (void)hipGetLastError();
        grid_blocks = cus * per_cu;
    }
    if (grid_blocks < 0) return;
    hipMemsetAsync((char*)d_ws + OFF_BAR, 0, XCD_BAR_WORDS * 4, stream);
    Params p{};
    const float** pp = (const float**)&p;
    for (int i = 0; i < 21; ++i) pp[i] = (const float*)d_in[i];
    p.out = (float*)d_out; p.ws = (unsigned char*)d_ws;
    p.ph_lo = 0; p.ph_hi = N_PHASES;
    void* args[] = {&p};
    hipError_t e = hipLaunchCooperativeKernel((const void*)mega, dim3(grid_blocks), dim3(NTHREADS), args, LDS_BYTES, stream);
    if (e != hipSuccess) fprintf(stderr, "cooperative launch failed: %s (grid %d)\n", hipGetErrorString(e), grid_blocks);
}
```

```cpp
#include <hip/hip_runtime.h>
#include <hip/hip_cooperative_groups.h>
#include <cstdio>
#include <cstdint>
namespace cg = cooperative_groups;


#define LAS __attribute__((address_space(3)))
typedef unsigned short bf16_t;
typedef short bf16x8 __attribute__((ext_vector_type(8)));
typedef float f32x4 __attribute__((ext_vector_type(4)));
typedef unsigned u32x4 __attribute__((ext_vector_type(4)));

constexpr int NTOK = 24576, DM = 2048, SEQL = 8192, INC = 12288;
constexpr int TCH = 32, NCHK = 256, SGRP = 128, UROWS = 768, UKK = 768;
constexpr int NTHREADS = 512, LDS_BYTES = 131072 + 16;
constexpr size_t MiB = 1048576;
constexpr size_t OFF_WINT = 0, OFF_GLUT = 48 * MiB, OFF_PAT = 56 * MiB, OFF_PBT = 64 * MiB, OFF_WOT = 72 * MiB, OFF_POOLT = 80 * MiB,
                 OFF_MG = 82 * MiB, OFF_BT = 178 * MiB, OFF_H = 210 * MiB, OFF_RA = 306 * MiB, OFF_RB = 450 * MiB, OFF_RC = 546 * MiB,
                 OFF_RD = 642 * MiB, WS_END = 738 * MiB;

struct Params {
    const float* x_prompt; const float* x_sample; const float* norm_w; const float* w_in; const float* gate_b;
    const float* lam_re; const float* lam_im; const float* log_dt; const float* b_re; const float* b_im; const float* c_re; const float* c_im;
    const float* ssm_d; const float* glu_w; const float* glu_b; const float* pool_w; const float* pool_scale;
    const float* proj_a; const float* proj_b; const float* w_out; const float* final_norm_w;
    float* out; unsigned char* ws; int ph_lo, ph_hi;
};

typedef __bf16 bf16x2_t __attribute__((ext_vector_type(2)));
typedef float f32x2_t __attribute__((ext_vector_type(2)));
__device__ __forceinline__ unsigned pk_bf16(float lo, float hi) { f32x2_t v = {lo, hi}; bf16x2_t b = __builtin_convertvector(v, bf16x2_t); return __builtin_bit_cast(unsigned, b); }
__device__ __forceinline__ float bf_lo(unsigned w) { return __uint_as_float(w << 16); }
__device__ __forceinline__ float bf_hi(unsigned w) { return __uint_as_float(w & 0xffff0000u); }
__device__ __forceinline__ float sigmoidf_(float x) { return __builtin_amdgcn_rcpf(1.0f + __expf(-x)); }
__device__ __forceinline__ float siluf_(float x) { return x * sigmoidf_(x); }
__device__ __forceinline__ float gelu_tanh_(float x) { return x * sigmoidf_(1.5957691216057308f * (x + 0.044715f * x * x * x)); }
__device__ __forceinline__ void unpack8(const u32x4 w, float (&v)[8]) { v[0] = bf_lo(w.x); v[1] = bf_hi(w.x); v[2] = bf_lo(w.y); v[3] = bf_hi(w.y); v[4] = bf_lo(w.z); v[5] = bf_hi(w.z); v[6] = bf_lo(w.w); v[7] = bf_hi(w.w); }
__device__ __forceinline__ u32x4 pack8(const float (&v)[8]) { u32x4 w; w.x = pk_bf16(v[0], v[1]); w.y = pk_bf16(v[2], v[3]); w.z = pk_bf16(v[4], v[5]); w.w = pk_bf16(v[6], v[7]); return w; }
__device__ __forceinline__ void lam_pow(float lr, float li, float dt, int n, float& re, float& im) {
    const float a = lr * dt, b = li * dt; const float m = expf(a * (float)n);
    const double ang = (double)b * (double)n; const double k = rint(ang * 0.15915494309189535); const float r = (float)(ang - k * 6.283185307179586);
    re = m * cosf(r); im = m * sinf(r);
}

namespace pg8 {
#ifndef EPI_NP1
#define EPI_NP1 4
#endif
#ifndef EPI_NP2
#define EPI_NP2 4
#endif
#ifndef EPI_NPF
#define EPI_NPF 4
#endif
#ifndef EPI_NPR
#define EPI_NPR 4
#endif
constexpr int BM = 256, BK = 64, HALF = 128, HTB = HALF * BK * 2, STAGE_BYTES = 8 * HTB, NXCD = 8, WGM = 8;
__device__ __forceinline__ int lds_byte(int r, int c) { const int st = (r >> 4) * 2 + (c >> 5), rr = r & 15, cc = c & 31, ob = rr * 64 + cc * 2; return st * 1024 + (ob ^ (((ob >> 9) & 1) << 5)); }
__device__ __forceinline__ void stage_rc(int b, int& R, int& C) { const int st = b / 1024, sb = b % 1024, swz = sb ^ (((sb >> 9) & 1) << 5); R = (st >> 1) * 16 + swz / 64; C = (st & 1) * 32 + (swz % 64) / 2; }
__device__ __forceinline__ int perm32(int rho) { const int n = rho >> 4, i = rho & 15; return 8 * (i >> 2) + 4 * n + (i & 3); }

struct Unit { int pm, pn, b; };
struct Gemm { const bf16_t* A; const bf16_t* Bt; int lda, ldb, K, kgrp; size_t sA, sB;
    __device__ __forceinline__ const char* a_ptr(const Unit& u) const { return (const char*)(A + (size_t)u.b * sA + (size_t)u.pm * BM * (kgrp == 3 ? 16 : lda) + (kgrp == 1 ? (u.pn >> 1) * K : 0)); }
    __device__ __forceinline__ const char* b_ptr(const Unit& u) const { return (const char*)(Bt + (size_t)u.b * sB + (size_t)u.pn * (kgrp == 2 ? 128 : BM) * ldb); }
};
struct StaticOrder {
    int nM, nN, nwg, G, c, rev = 0;
    __device__ void init(int M, int N, int G_, int c_) { nM = M / BM; nN = N / BM; nwg = nM * nN; G = G_; c = c_; }
    __device__ bool next(int i, Unit& u) const {
        const long L = (long)i * G + c; if (L >= nwg) return false;
        int wgid = (int)L; { const int q = nwg / NXCD, r = nwg % NXCD, xcd = wgid % NXCD, off = wgid / NXCD; wgid = (xcd < r ? xcd * (q + 1) : r * (q + 1) + (xcd - r) * q) + off; }
        if (rev) wgid = nwg - 1 - wgid;
        const int nig = WGM * nN, gid = wgid / nig, fm = gid * WGM, gsz = (nM - fm) < WGM ? (nM - fm) : WGM;
        u.pm = fm + ((wgid % nig) % gsz); u.pn = (wgid % nig) / gsz; u.b = 0; return true;
    }
};
struct BatchOrder {
    int nM, nN, per, nwg, G, c, rev = 0;
    __device__ void init(int nB, int nM_, int nN_, int G_, int c_) { nM = nM_; nN = nN_; per = nM_ * nN_; nwg = nB * per; G = G_; c = c_; }
    __device__ bool next(int i, Unit& u) const {
        const long L = (long)i * G + c; if (L >= nwg) return false;
        int wgid = (int)L; { const int q = nwg / NXCD, r = nwg % NXCD, xcd = wgid % NXCD, off = wgid / NXCD; wgid = (xcd < r ? xcd * (q + 1) : r * (q + 1) + (xcd - r) * q) + off; }
        if (rev) wgid = nwg - 1 - wgid;
        u.b = wgid / per; const int r2 = wgid % per; u.pm = r2 % nM; u.pn = r2 / nM; return true;
    }
};

enum { E_G1A = 0, E_G1B, E_G1C, E_S5P2, E_GLU, E_POOL, E_PA, E_PB, E_RAW, E_MERGE, E_RES0, E_RES1 };
template <int MODE> struct EpiB {
    static constexpr bool PERM = true;
    bf16_t* O0; bf16_t* O1; const bf16_t* X0; const float* bias; const float* XF1 = nullptr; float* XO = nullptr;
    __device__ __forceinline__ void operator()(const f32x4 (&acc)[2][2][4][2], const Unit& u, int wr, int wc, int fr, int fq) const {
        const int colb = u.pn * BM + wc * 64 + 8 * fq;
        f32x4 bv[2][2];
        if (MODE == E_G1C || MODE == E_GLU || MODE == E_POOL) {
#pragma unroll
            for (int bj = 0; bj < 2; ++bj) { bv[bj][0] = *(const f32x4*)(bias + colb + bj * 32); bv[bj][1] = *(const f32x4*)(bias + colb + bj * 32 + 4); }
        }
        if (MODE == E_RES0) {
            const float* X = (u.pm < 32) ? bias : XF1;
            const size_t lane_off = (size_t)(u.pm * BM + wr * 64 + fr) * DM + colb;
#define EPI_OFF(s_) (lane_off + (size_t)((((s_) >> 3) & 1) * HALF + (((s_) >> 1) & 3) * 16) * DM + ((s_) & 1) * 32)
#pragma unroll
            for (int r0 = 0; r0 < 16; r0 += EPI_NPR) {
                f32x4 xa[EPI_NPR], xb[EPI_NPR];
#pragma unroll
                for (int q = 0; q < EPI_NPR; ++q) { xa[q] = *(const f32x4*)(X + EPI_OFF(r0 + q)); xb[q] = *(const f32x4*)(X + EPI_OFF(r0 + q) + 4); }
#pragma unroll
                for (int q = 0; q < EPI_NPR; ++q) { const int st = r0 + q, ai = st >> 3, m = (st >> 1) & 3, bj = st & 1; xa[q] += acc[ai][bj][m][0]; xb[q] += acc[ai][bj][m][1]; }
#pragma unroll
                for (int q = 0; q < EPI_NPR; ++q) { u32x4 w; w.x = pk_bf16(xa[q][0], xa[q][1]); w.y = pk_bf16(xa[q][2], xa[q][3]); w.z = pk_bf16(xb[q][0], xb[q][1]); w.w = pk_bf16(xb[q][2], xb[q][3]);
                    *(u32x4*)(O0 + EPI_OFF(r0 + q)) = w; }
            }
#undef EPI_OFF
            return;
        }
        if (MODE == E_RES1) {
            const size_t lane_off = (size_t)(u.pm * BM + wr * 64 + fr) * DM + colb;
#define EPI_OFF(s_) (lane_off + (size_t)((((s_) >> 3) & 1) * HALF + (((s_) >> 1) & 3) * 16) * DM + ((s_) & 1) * 32)
#pragma unroll
            for (int r0 = 0; r0 < 16; r0 += 4) {
                u32x4 lx[4]; f32x4 ya[4], yb[4];
#pragma unroll
                for (int q = 0; q < 4; ++q) lx[q] = *(const u32x4*)(X0 + EPI_OFF(r0 + q));
#pragma unroll
                for (int q = 0; q < 4; ++q) { const int st = r0 + q, ai = st >> 3, m = (st >> 1) & 3, bj = st & 1; float a[8]; unpack8(lx[q], a);
                    ya[q] = acc[ai][bj][m][0] + (f32x4){a[0], a[1], a[2], a[3]}; yb[q] = acc[ai][bj][m][1] + (f32x4){a[4], a[5], a[6], a[7]}; }
#pragma unroll
                for (int q = 0; q < 4; ++q) { *(f32x4*)(XO + EPI_OFF(r0 + q)) = ya[q]; *(f32x4*)(XO + EPI_OFF(r0 + q) + 4) = yb[q]; }
            }
#undef EPI_OFF
            return;
        }
        if (MODE == E_RAW) {
#pragma unroll
            for (int ai = 0; ai < 2; ++ai)
#pragma unroll
                for (int m = 0; m < 4; ++m)
#pragma unroll
                    for (int bj = 0; bj < 2; ++bj) { float v[8];
#pragma unroll
                        for (int j = 0; j < 4; ++j) { v[j] = acc[ai][bj][m][0][j]; v[4 + j] = acc[ai][bj][m][1][j]; }
                        *(u32x4*)(O0 + (size_t)(u.pm * BM + ai * HALF + wr * 64 + m * 16 + fr) * DM + colb + bj * 32) = pack8(v); }
            return;
        }
        if (MODE == E_MERGE) {
            const int d0 = u.pn * 128 + wc * 32 + 8 * fq;
            const f32x4 ba0 = *(const f32x4*)(bias + d0), ba1 = *(const f32x4*)(bias + d0 + 4), bb0 = *(const f32x4*)(bias + DM + d0), bb1 = *(const f32x4*)(bias + DM + d0 + 4);
            const size_t lane_off = (size_t)(u.pm * BM + wr * 64 + fr) * DM + d0;
#pragma unroll
            for (int ai = 0; ai < 2; ++ai) {
                u32x4 la[4], lb[4];
#pragma unroll
                for (int m = 0; m < 4; ++m) { const size_t idx = lane_off + (size_t)(ai * HALF + m * 16) * DM; la[m] = *(const u32x4*)(O0 + idx); lb[m] = *(const u32x4*)(X0 + idx); }
#pragma unroll
                for (int m = 0; m < 4; ++m) { float a[8], b[8], v[8]; unpack8(la[m], a); unpack8(lb[m], b);
#pragma unroll
                    for (int j = 0; j < 4; ++j) {
                        v[j] = sigmoidf_(acc[ai][0][m][0][j] + ba0[j]) * a[j] + sigmoidf_(acc[ai][1][m][0][j] + bb0[j]) * b[j];
                        v[4 + j] = sigmoidf_(acc[ai][0][m][1][j] + ba1[j]) * a[4 + j] + sigmoidf_(acc[ai][1][m][1][j] + bb1[j]) * b[4 + j]; }
                    la[m] = pack8(v); }
#pragma unroll
                for (int m = 0; m < 4; ++m) *(u32x4*)(O0 + lane_off + (size_t)(ai * HALF + m * 16) * DM) = la[m];
            }
            return;
        }
        if (MODE == E_GLU || MODE == E_POOL || MODE == E_PA || MODE == E_PB) {
            constexpr bool TWO = (MODE == E_GLU || MODE == E_PB);
            constexpr int NP = TWO ? EPI_NP2 : EPI_NP1;
            bf16_t* Ob = (MODE == E_PB) ? O1 : O0;
            const size_t lane_off = (size_t)(u.pm * BM + wr * 64 + fr) * DM + colb;
            const size_t lane_offx = ((size_t)(colb >> 4) * NTOK + (u.pm * BM + wr * 64 + fr)) * 16 + (colb & 15);
#define EPI_OFF(s_) (lane_off + (size_t)((((s_) >> 3) & 1) * HALF + (((s_) >> 1) & 3) * 16) * DM + ((s_) & 1) * 32)
#pragma unroll
            for (int r0 = 0; r0 < 16; r0 += NP) {
                u32x4 la[NP], lb[NP];
#pragma unroll
                for (int q = 0; q < NP; ++q) { la[q] = *(const u32x4*)(Ob + EPI_OFF(r0 + q));
                    if (MODE == E_GLU) { const int s_ = r0 + q;
                        lb[q] = *(const u32x4*)(X0 + lane_offx + (size_t)(((s_ >> 3) & 1) * HALF + ((s_ >> 1) & 3) * 16) * 16 + (size_t)(s_ & 1) * 2 * NTOK * 16); }
                    else if (TWO) lb[q] = *(const u32x4*)(X0 + EPI_OFF(r0 + q)); }
#pragma unroll
                for (int q = 0; q < NP; ++q) {
                    const int st = r0 + q, ai = st >> 3, m = (st >> 1) & 3, bj = st & 1;
                    float v[8], a[8], b[8];
#pragma unroll
                    for (int j = 0; j < 4; ++j) { v[j] = acc[ai][bj][m][0][j]; v[4 + j] = acc[ai][bj][m][1][j]; }
                    unpack8(la[q], a);
                    if (TWO) unpack8(lb[q], b);
                    if (MODE == E_GLU) {
#pragma unroll
                        for (int j = 0; j < 4; ++j) { v[j] = b[j] * sigmoidf_(v[j] + bv[bj][0][j]) * a[j]; v[4 + j] = b[4 + j] * sigmoidf_(v[4 + j] + bv[bj][1][j]) * a[4 + j]; }
                    } else if (MODE == E_POOL) {
#pragma unroll
                        for (int j = 0; j < 4; ++j) { v[j] = v[j] * bv[bj][0][j] * a[j]; v[4 + j] = v[4 + j] * bv[bj][1][j] * a[4 + j]; }
                    } else if (MODE == E_PA) {
#pragma unroll
                        for (int j = 0; j < 8; ++j) v[j] *= a[j];
                    } else {
#pragma unroll
                        for (int j = 0; j < 8; ++j) v[j] = b[j] + a[j] * v[j];
                    }
                    la[q] = pack8(v);
                }
#pragma unroll
                for (int q = 0; q < NP; ++q) *(u32x4*)(Ob + EPI_OFF(r0 + q)) = la[q];
            }
#undef EPI_OFF
            return;
        }
#pragma unroll
        for (int ai = 0; ai < 2; ++ai)
#pragma unroll
            for (int m = 0; m < 4; ++m) {
                const int row = u.pm * BM + ai * HALF + wr * 64 + m * 16 + fr;
#pragma unroll
                for (int bj = 0; bj < 2; ++bj) {
                    const int col = colb + bj * 32;
                    float v[8];
#pragma unroll
                    for (int j = 0; j < 4; ++j) { v[j] = acc[ai][bj][m][0][j]; v[4 + j] = acc[ai][bj][m][1][j]; }
                    if (MODE == E_G1A || MODE == E_G1B || MODE == E_G1C) {
                        const int seg = u.pn >> 3, cc = col & 2047;
                        if (MODE == E_G1C) {
#pragma unroll
                            for (int j = 0; j < 4; ++j) { v[j] = sigmoidf_(v[j] + bv[bj][0][j]); v[4 + j] = sigmoidf_(v[4 + j] + bv[bj][1][j]); }
                        } else if (seg == 1) {
#pragma unroll
                            for (int j = 0; j < 8; ++j) v[j] = siluf_(v[j]);
                        }
                        bf16_t* dst;
                        if (MODE == E_G1A && seg == 0) {
                            const int g = cc >> 4, c0 = cc & 15, sq = row >> 13, tl = row & 8191, ch = tl >> 5, s = tl & 31;
                            dst = O0 + ((size_t)(g * UROWS + sq * NCHK + ch) * UKK + s * 16 + c0);
                        } else dst = (seg ? O1 : O0) + (size_t)row * DM + cc;
                        *(u32x4*)dst = pack8(v);
                    } else if (MODE == E_S5P2) {
                        const int ch = row & 255, t = col >> 4, c0 = col & 15;
                        const size_t tok = (size_t)u.pm * SEQL + ch * TCH + t;
#pragma unroll
                        for (int j = 0; j < 8; ++j) v[j] = gelu_tanh_(v[j]);
                        *(u32x4*)(O0 + ((size_t)u.b * NTOK + tok) * 16 + c0) = pack8(v);
                    }
                }
                asm volatile("" ::: "memory");
            }
    }
};
enum { F_S5P1 = 0, F_WOUT };
template <int MODE> struct EpiF {
    static constexpr bool PERM = false;
    float* C; const float* X0; const float* X1;
    __device__ __forceinline__ void operator()(const f32x4 (&acc)[2][2][4][2], const Unit& u, int wr, int wc, int fr, int fq) const {
        const int col0 = u.pn * BM + wc * 32 + 4 * fq;
        const float* X = (u.pm < 32) ? X0 : X1;
        if (MODE == F_WOUT) {
            const size_t lane_off = (size_t)(u.pm * BM + wr * 64 + fr) * DM + col0;
#define EPI_OFF(s_) (lane_off + (size_t)((((s_) >> 3) & 1) * HALF + (((s_) >> 1) & 3) * 16) * DM + ((s_) & 1) * HALF)
#pragma unroll
            for (int r0 = 0; r0 < 16; r0 += EPI_NPF) {
                f32x4 xr[EPI_NPF][2];
#pragma unroll
                for (int q = 0; q < EPI_NPF; ++q)
#pragma unroll
                    for (int n = 0; n < 2; ++n) xr[q][n] = *(const f32x4*)(X + EPI_OFF(r0 + q) + n * 16);
#pragma unroll
                for (int q = 0; q < EPI_NPF; ++q) { const int st = r0 + q, ai = st >> 3, m = (st >> 1) & 3, bj = st & 1;
#pragma unroll
                    for (int n = 0; n < 2; ++n) xr[q][n] += acc[ai][bj][m][n]; }
#pragma unroll
                for (int q = 0; q < EPI_NPF; ++q)
#pragma unroll
                    for (int n = 0; n < 2; ++n) *(f32x4*)(C + EPI_OFF(r0 + q) + n * 16) = xr[q][n];
            }
#undef EPI_OFF
            return;
        }
#pragma unroll
        for (int ai = 0; ai < 2; ++ai)
#pragma unroll
            for (int m = 0; m < 4; ++m) {
                const int row = u.pm * BM + ai * HALF + wr * 64 + m * 16 + fr;
#pragma unroll
                for (int bj = 0; bj < 2; ++bj)
#pragma unroll
                    for (int n = 0; n < 2; ++n) {
                        const int col = col0 + bj * HALF + n * 16;
                        *(f32x4*)(C + ((size_t)u.b * UROWS + row) * 256 + col) = acc[ai][bj][m][n];
                    }
                asm volatile("" ::: "memory");
            }
    }
};

#ifndef PG8_SP2
#define PG8_SP2 1
#endif
#ifndef PG8_ALIGN
#define PG8_ALIGN 1
#endif
template <class Epi, class Sched>
__device__ __forceinline__ void gemm_phase(LAS unsigned char* lds, const int tid, const Gemm g, const Sched& S, const Epi& E) {
    constexpr bool SP2 = PG8_SP2 != 0, ALIGN_EPI = PG8_ALIGN != 0;
    const int wid = __builtin_amdgcn_readfirstlane(tid >> 6), lane = tid & 63, wr = wid >> 2, wc = wid & 3, fr = lane & 15, fq = lane >> 4;
    const int K = g.K, nt = K / BK;
    unsigned voffA[2], voffB[2];
#pragma unroll
    for (int i = 0; i < 2; ++i) { int R, C; stage_rc(tid * 16 + i * 8192, R, C); const int Rb = Epi::PERM ? ((R >> 5) * (g.kgrp == 2 ? 32 : 64) + perm32(R & 31)) : R;
        voffA[i] = g.kgrp == 3 ? (unsigned)((C >> 4) * (NTOK * 16) + R * 16 + (C & 15)) * 2u : (unsigned)(R * g.lda + C) * 2u; voffB[i] = (unsigned)(Rb * g.ldb + C) * 2u; }
    const size_t kstep = (size_t)(BK * 2), kstepA = g.kgrp == 3 ? (size_t)4 * NTOK * 16 * 2 : kstep;
    const size_t hstepA = (size_t)HALF * (g.kgrp == 3 ? 16 : g.lda) * 2, hstepB = (size_t)(Epi::PERM ? (g.kgrp == 2 ? 2048 : 32) : HALF) * g.ldb * 2;
    const unsigned ldsw = (unsigned)wid * 1024u;
    const int aoff = lds_byte(wr * 64 + fr, fq * 8), boff = lds_byte(wc * 32 + fr, fq * 8);
#define PG8_SA(b, h) (((b) * 2 + (h)) * HTB)
#define PG8_SB(b, h) ((4 + (b) * 2 + (h)) * HTB)
#define PG8_STAGE(bufoff, gbase, voff) do { _Pragma("unroll") for (int _i = 0; _i < 2; ++_i) \
        __builtin_amdgcn_global_load_lds((const unsigned*)((const char*)(gbase) + (voff)[_i]), (LAS unsigned*)(lds + (bufoff) + ldsw + _i * 8192), 16, 0, 0); } while (0)
#define PG8_LDA(dst, b, h) do { _Pragma("unroll") for (int m = 0; m < 4; ++m) _Pragma("unroll") for (int k = 0; k < 2; ++k) dst[m][k] = *(const LAS bf16x8*)(lds + PG8_SA(b, h) + aoff + m * 2048 + k * 1024); } while (0)
#define PG8_LDB(dst, b, h) do { _Pragma("unroll") for (int n = 0; n < 2; ++n) _Pragma("unroll") for (int k = 0; k < 2; ++k) dst[n][k] = *(const LAS bf16x8*)(lds + PG8_SB(b, h) + boff + n * 2048 + k * 1024); } while (0)
#define PG8_MMA(ai, bj, At, Bt) do { __builtin_amdgcn_s_setprio(1); _Pragma("unroll") for (int m = 0; m < 4; ++m) _Pragma("unroll") for (int n = 0; n < 2; ++n) _Pragma("unroll") for (int k = 0; k < 2; ++k) \
        acc[ai][bj][m][n] = __builtin_amdgcn_mfma_f32_16x16x32_bf16(Bt[n][k], At[m][k], acc[ai][bj][m][n], 0, 0, 0); __builtin_amdgcn_s_setprio(0); } while (0)
#define PG8_WAIT_V(n) asm volatile("s_waitcnt vmcnt(" #n ")" ::: "memory")
#define PG8_WAIT_L(n) asm volatile("s_waitcnt lgkmcnt(" #n ")" ::: "memory")
#define PG8_BAR __builtin_amdgcn_s_barrier()
#define PG8_SCHED __builtin_amdgcn_sched_barrier(0)
    Unit cur, nxt; int ui = 0;
    if (!S.next(0, cur)) return;
    f32x4 acc[2][2][4][2];
#pragma unroll
    for (int a = 0; a < 2; ++a)
#pragma unroll
        for (int b = 0; b < 2; ++b)
#pragma unroll
            for (int m = 0; m < 4; ++m)
#pragma unroll
                for (int n = 0; n < 2; ++n) acc[a][b][m][n] = (f32x4){0.f, 0.f, 0.f, 0.f};
    bf16x8 At[4][2], B0[2][2], B1[2][2];
    const char* cA = g.a_ptr(cur); const char* cB = g.b_ptr(cur);
    if constexpr (SP2) {
        PG8_STAGE(PG8_SB(0, 0), cB, voffB); PG8_STAGE(PG8_SB(0, 1), cB + hstepB, voffB); PG8_STAGE(PG8_SA(0, 0), cA, voffA); PG8_STAGE(PG8_SA(0, 1), cA + hstepA, voffA);
        PG8_STAGE(PG8_SB(1, 0), cB + kstep, voffB); PG8_STAGE(PG8_SA(1, 0), cA + kstepA, voffA); PG8_STAGE(PG8_SB(1, 1), cB + hstepB + kstep, voffB);
        if (wr == 1) PG8_BAR;
        PG8_WAIT_V(8); PG8_BAR;
        PG8_WAIT_V(6); PG8_BAR;
    } else {
    PG8_STAGE(PG8_SB(0, 0), cB, voffB); PG8_STAGE(PG8_SA(0, 0), cA, voffA); PG8_STAGE(PG8_SB(0, 1), cB + hstepB, voffB); PG8_STAGE(PG8_SA(0, 1), cA + hstepA, voffA);
    if (wr == 1) PG8_BAR;
    PG8_WAIT_V(4); PG8_BAR;
    PG8_STAGE(PG8_SB(1, 0), cB + kstep, voffB); PG8_STAGE(PG8_SA(1, 0), cA + kstepA, voffA); PG8_STAGE(PG8_SB(1, 1), cB + hstepB + kstep, voffB);
    PG8_WAIT_V(6); PG8_BAR;
    }
    for (;;) {
        const bool has_next = S.next(ui + 1, nxt);
        const char* nA = has_next ? g.a_ptr(nxt) : cA; const char* nB = has_next ? g.b_ptr(nxt) : cB;
        for (int t = 0; t < nt; t += 2) {
            const bool last = (t == nt - 2);
            const char* a1 = cA + (size_t)(t + 1) * kstepA;
            const char* a2 = last ? nA : cA + (size_t)(t + 2) * kstepA; const char* b2 = last ? nB : cB + (size_t)(t + 2) * kstep;
            const char* a3 = a2 + kstepA; const char* b3 = b2 + kstep;
            if constexpr (SP2) {
            PG8_LDB(B0, 0, 0); PG8_LDB(B1, 0, 1); PG8_SCHED; PG8_LDA(At, 0, 0); PG8_STAGE(PG8_SA(1, 1), a1 + hstepA, voffA);
            PG8_WAIT_V(8); PG8_WAIT_L(0); PG8_BAR; PG8_MMA(0, 0, At, B0); PG8_MMA(0, 1, At, B1); PG8_BAR; PG8_SCHED;
            PG8_LDA(At, 0, 1); PG8_STAGE(PG8_SB(0, 0), b2, voffB); PG8_STAGE(PG8_SB(0, 1), b2 + hstepB, voffB); PG8_STAGE(PG8_SA(0, 0), a2, voffA);
            PG8_WAIT_V(8); PG8_WAIT_L(0); PG8_BAR; PG8_MMA(1, 0, At, B0); PG8_MMA(1, 1, At, B1); PG8_BAR; PG8_SCHED;
            PG8_LDB(B0, 1, 0); PG8_LDB(B1, 1, 1); PG8_SCHED; PG8_LDA(At, 1, 0); PG8_STAGE(PG8_SA(0, 1), a2 + hstepA, voffA);
            PG8_WAIT_V(8); PG8_WAIT_L(0); PG8_BAR; PG8_MMA(0, 0, At, B0); PG8_MMA(0, 1, At, B1); PG8_BAR; PG8_SCHED;
            PG8_LDA(At, 1, 1); PG8_STAGE(PG8_SB(1, 0), b3, voffB); PG8_STAGE(PG8_SB(1, 1), b3 + hstepB, voffB); PG8_STAGE(PG8_SA(1, 0), a3, voffA);
            PG8_WAIT_V(8); PG8_WAIT_L(0); PG8_BAR; PG8_MMA(1, 0, At, B0); PG8_MMA(1, 1, At, B1); PG8_BAR; PG8_SCHED;
            } else {
            PG8_LDB(B0, 0, 0); PG8_SCHED; PG8_LDA(At, 0, 0); PG8_STAGE(PG8_SA(1, 1), a1 + hstepA, voffA);
            PG8_WAIT_L(8); PG8_BAR; PG8_WAIT_L(0); PG8_MMA(0, 0, At, B0); PG8_BAR; PG8_SCHED;
            PG8_LDB(B1, 0, 1); PG8_STAGE(PG8_SB(0, 0), b2, voffB);
            PG8_BAR; PG8_WAIT_L(0); PG8_MMA(0, 1, At, B1); PG8_BAR;
            PG8_LDA(At, 0, 1); PG8_STAGE(PG8_SA(0, 0), a2, voffA);
            PG8_BAR; PG8_WAIT_L(0); PG8_MMA(1, 0, At, B0); PG8_BAR; PG8_SCHED;
            PG8_STAGE(PG8_SB(0, 1), b2 + hstepB, voffB);
            PG8_WAIT_V(6); PG8_BAR; PG8_MMA(1, 1, At, B1); PG8_BAR;
            PG8_LDB(B0, 1, 0); PG8_SCHED; PG8_LDA(At, 1, 0); PG8_STAGE(PG8_SA(0, 1), a2 + hstepA, voffA);
            PG8_WAIT_L(8); PG8_BAR; PG8_WAIT_L(0); PG8_MMA(0, 0, At, B0); PG8_BAR; PG8_SCHED;
            PG8_LDB(B1, 1, 1); PG8_STAGE(PG8_SB(1, 0), b3, voffB);
            PG8_BAR; PG8_WAIT_L(0); PG8_MMA(0, 1, At, B1); PG8_BAR;
            PG8_LDA(At, 1, 1); PG8_STAGE(PG8_SA(1, 0), a3, voffA);
            PG8_BAR; PG8_WAIT_L(0); PG8_MMA(1, 0, At, B0); PG8_BAR; PG8_SCHED;
            PG8_STAGE(PG8_SB(1, 1), b3 + hstepB, voffB);
            PG8_WAIT_V(6); PG8_BAR; PG8_MMA(1, 1, At, B1); PG8_BAR;
            }
        }
        if constexpr (ALIGN_EPI) { if (wr == 0) PG8_BAR; }
        E(acc, cur, wr, wc, fr, fq);
        if (!has_next) break;
#pragma unroll
        for (int a = 0; a < 2; ++a)
#pragma unroll
            for (int b = 0; b < 2; ++b)
#pragma unroll
                for (int m = 0; m < 4; ++m)
#pragma unroll
                    for (int n = 0; n < 2; ++n) acc[a][b][m][n] = (f32x4){0.f, 0.f, 0.f, 0.f};
        cur = nxt; cA = nA; cB = nB; ++ui;
        if constexpr (ALIGN_EPI) { if (wr == 1) PG8_BAR; }
    }
    PG8_WAIT_V(0);
    if constexpr (!ALIGN_EPI) { if (wr == 0) PG8_BAR; }
    PG8_BAR;
#undef PG8_SA
#undef PG8_SB
#undef PG8_STAGE
#undef PG8_LDA
#undef PG8_LDB
#undef PG8_MMA
#undef PG8_WAIT_V
#undef PG8_WAIT_L
#undef PG8_BAR
#undef PG8_SCHED
}
}

__device__ __forceinline__ void rms_phase_b(const int tid, const bf16_t* x, const float* w, bf16_t* outp) {
    const int wid = tid >> 6, lane = tid & 63;
    for (int row = blockIdx.x * 8 + wid; row < NTOK; row += gridDim.x * 8) {
        const bf16_t* xr = x + (size_t)row * DM;
        float v[4][8];
#pragma unroll
        for (int j = 0; j < 4; ++j) unpack8(*(const u32x4*)(xr + j * 512 + lane * 8), v[j]);
        float ss = 0.f;
#pragma unroll
        for (int j = 0; j < 4; ++j)
#pragma unroll
            for (int q = 0; q < 8; ++q) ss += v[j][q] * v[j][q];
#pragma unroll
        for (int o = 32; o >= 1; o >>= 1) ss += __shfl_xor(ss, o);
        const float r = 1.0f / sqrtf(ss * (1.0f / DM) + 1e-6f);
#pragma unroll
        for (int j = 0; j < 4; ++j) {
            const f32x4 w0 = *(const f32x4*)(w + j * 512 + lane * 8), w1 = *(const f32x4*)(w + j * 512 + lane * 8 + 4);
            float o[8];
#pragma unroll
            for (int q = 0; q < 4; ++q) { o[q] = v[j][q] * r * w0[q]; o[4 + q] = v[j][4 + q] * r * w1[q]; }
            *(u32x4*)(outp + (size_t)row * DM + j * 512 + lane * 8) = pack8(o);
        }
    }
}

template <bool TOBF>
__device__ __forceinline__ void rms_phase(const int tid, const float* x0, const float* x1, const float* w, void* outp) {
    const int wid = tid >> 6, lane = tid & 63;
    for (int row = blockIdx.x * 8 + wid; row < NTOK; row += gridDim.x * 8) {
        const float* xr = (row < SEQL ? x0 : x1) + (size_t)row * DM;
        f32x4 v[8];
#pragma unroll
        for (int j = 0; j < 4; ++j) { v[2 * j] = *(const f32x4*)(xr + j * 512 + lane * 8); v[2 * j + 1] = *(const f32x4*)(xr + j * 512 + lane * 8 + 4); }
        float ss = 0.f;
#pragma unroll
        for (int j = 0; j < 8; ++j) ss += v[j][0] * v[j][0] + v[j][1] * v[j][1] + v[j][2] * v[j][2] + v[j][3] * v[j][3];
#pragma unroll
        for (int o = 32; o >= 1; o >>= 1) ss += __shfl_xor(ss, o);
        const float r = 1.0f / sqrtf(ss * (1.0f / DM) + 1e-6f);
#pragma unroll
        for (int j = 0; j < 4; ++j) {
            const f32x4 w0 = *(const f32x4*)(w + j * 512 + lane * 8), w1 = *(const f32x4*)(w + j * 512 + lane * 8 + 4);
            const f32x4 a = v[2 * j] * r * w0, b = v[2 * j + 1] * r * w1;
            if (TOBF) { u32x4 p; p.x = pk_bf16(a[0], a[1]); p.y = pk_bf16(a[2], a[3]); p.z = pk_bf16(b[0], b[1]); p.w = pk_bf16(b[2], b[3]);
                *(u32x4*)((bf16_t*)outp + (size_t)row * DM + j * 512 + lane * 8) = p; }
            else { float* o = (float*)outp + (size_t)row * DM + j * 512 + lane * 8; *(f32x4*)o = a; *(f32x4*)(o + 4) = b; }
        }
    }
}

__device__ __forceinline__ void poole_phase(const int tid, const bf16_t* UB, bf16_t* Pp, LAS unsigned char* lds) {
    const int o = tid & 63, w8 = tid >> 6;
    u32x4 v[10];
    int item = blockIdx.x; asm volatile("" : "+s"(item));
#define POOLE_LOAD(item_) do { const int t0_ = ((item_) >> 2) * 64, tl0_ = t0_ & (SEQL - 1), cg_ = (item_) & 3; const size_t sb_ = (size_t)(t0_ - tl0_); \
        _Pragma("unroll") for (int k = 0; k < 10; ++k) { const int tl = tl0_ - 8 + w8 + 8 * k; v[k] = (u32x4){0u, 0u, 0u, 0u}; \
            if (tl >= 0 && tl < SEQL) v[k] = *(const u32x4*)(UB + (sb_ + tl) * DM + cg_ * 512 + o * 8); } } while (0)
    if (item < (NTOK / 64) * 4) POOLE_LOAD(item);
    while (item < (NTOK / 64) * 4) {
        const int tt = item >> 2, cg = item & 3, t0 = tt * 64, tl0 = t0 & (SEQL - 1), half = 1 << cg;
        const size_t seqbase = (size_t)(t0 - tl0);
#pragma unroll
        for (int k = 0; k < 10; ++k) *(LAS u32x4*)(lds + ((w8 + 8 * k) * 64 + o) * 16) = v[k];
        __syncthreads();
        item += gridDim.x;
        if (item < (NTOK / 64) * 4) POOLE_LOAD(item);
        { const int first = tl0 + w8 * 8; float sum[8];
#pragma unroll
          for (int j = 0; j < 8; ++j) sum[j] = 0.f;
          for (int s_ = first - half; s_ < first + half; ++s_) { float u[8]; unpack8(*(const LAS u32x4*)(lds + ((s_ - tl0 + 8) * 64 + o) * 16), u);
#pragma unroll
              for (int j = 0; j < 8; ++j) sum[j] += u[j]; }
#pragma unroll
          for (int q = 0; q < 8; ++q) { const int t = first + q, lo = t - half < 0 ? 0 : t - half, hi = t + half > SEQL ? SEQL : t + half; const float ic = 1.0f / (float)(hi - lo);
              float u[8], ov[8], a[8], b[8]; unpack8(*(const LAS u32x4*)(lds + ((t - tl0 + 8) * 64 + o) * 16), u);
#pragma unroll
              for (int j = 0; j < 8; ++j) ov[j] = sum[j] * ic - u[j];
              *(u32x4*)(Pp + (seqbase + t) * DM + cg * 512 + o * 8) = pack8(ov);
              unpack8(*(const LAS u32x4*)(lds + ((t + half - tl0 + 8) * 64 + o) * 16), a); unpack8(*(const LAS u32x4*)(lds + ((t - half - tl0 + 8) * 64 + o) * 16), b);
#pragma unroll
              for (int j = 0; j < 8; ++j) sum[j] += a[j] - b[j]; } }
        __syncthreads();
    }
#undef POOLE_LOAD
}

__device__ __forceinline__ void carry_wave(const Params& P, int l, const float* E, bf16_t* Ug, int g, int sq, int dir, int lane) {
    const int pi = ((l * 2 + dir) * SGRP + g) * 64 + lane;
    const float lr = fminf(P.lam_re[pi], -1e-4f), li = P.lam_im[pi], dt = expf(P.log_dt[(l * 2 + dir) * SGRP + g]);
    float ar, ai; lam_pow(lr, li, dt, TCH, ar, ai);
    float hr = 0.f, hi = 0.f;
    const float* Eb = E + ((size_t)g * UROWS + sq * NCHK) * 256 + dir * 128 + lane;
    bf16_t* Hb = Ug + ((size_t)g * UROWS + sq * NCHK) * UKK + 512 + dir * 128 + lane;
    for (int k0 = 0; k0 < NCHK; k0 += 32) {
        float er[32], ei[32];
#pragma unroll
        for (int j = 0; j < 32; ++j) { const int k = dir ? (NCHK - 1 - k0 - j) : (k0 + j); er[j] = Eb[(size_t)k * 256]; ei[j] = Eb[(size_t)k * 256 + 64]; }
#pragma unroll
        for (int j = 0; j < 32; ++j) { const int k = dir ? (NCHK - 1 - k0 - j) : (k0 + j);
            Hb[(size_t)k * UKK] = (bf16_t)(pk_bf16(hr, 0.f) & 0xffffu); Hb[(size_t)k * UKK + 64] = (bf16_t)(pk_bf16(hi, 0.f) & 0xffffu);
            const float nr = ar * hr - ai * hi + er[j], ni = ar * hi + ai * hr + ei[j]; hr = nr; hi = ni; }
    }
}

__device__ __forceinline__ void prep_phase(const int tid, unsigned char* ws, const Params& P, int l, LAS unsigned char* lds) {
    LAS float* LP = (LAS float*)lds;
    LAS float* BB = LP + 8448;
    LAS float* KT = BB + 4096;
    LAS float* CC = KT + 16128;
    bf16_t* Mg = (bf16_t*)(ws + OFF_MG); bf16_t* Bt = (bf16_t*)(ws + OFF_BT);
    const int nS = (int)gridDim.x < SGRP ? (int)gridDim.x : SGRP;
    for (int g = blockIdx.x; g < SGRP && (int)blockIdx.x < nS; g += nS) {
        if (tid < 128) {
            const int d = tid >> 6, p = tid & 63;
            const int pi = ((l * 2 + d) * SGRP + g) * 64 + p;
            const float lr = fminf(P.lam_re[pi], -1e-4f), li = P.lam_im[pi], dt = expf(P.log_dt[(l * 2 + d) * SGRP + g]);
            float ar, ai; lam_pow(lr, li, dt, 1, ar, ai);
            float re = 1.f, im = 0.f; LAS float* lp = LP + (d * 64 + p) * 33 * 2;
            for (int n = 0; n <= 32; ++n) { lp[n * 2] = re; lp[n * 2 + 1] = im; const float nr = re * ar - im * ai, ni = re * ai + im * ar; re = nr; im = ni; }
        }
        __syncthreads();
        for (int idx = tid; idx < 2048; idx += NTHREADS) {
            const int d = idx >> 10, p = (idx >> 4) & 63, c = idx & 15;
            const int pi = ((l * 2 + d) * SGRP + g) * 64 + p;
            const float lr = fminf(P.lam_re[pi], -1e-4f), li = P.lam_im[pi];
            const float ar = LP[((d * 64 + p) * 33 + 1) * 2], ai = LP[((d * 64 + p) * 33 + 1) * 2 + 1];
            const float den = lr * lr + li * li, nr = ((ar - 1.0f) * lr + ai * li) / den, ni = (ai * lr - (ar - 1.0f) * li) / den;
            const float br = P.b_re[(size_t)pi * 16 + c], bi = P.b_im[(size_t)pi * 16 + c];
            BB[idx] = nr * br - ni * bi; BB[2048 + idx] = nr * bi + ni * br;
            const size_t ci = ((size_t)((l * 2 + d) * SGRP + g) * 16 + c) * 64 + p;
            CC[((d * 16 + c) * 64 + p) * 2] = P.c_re[ci]; CC[((d * 16 + c) * 64 + p) * 2 + 1] = P.c_im[ci];
        }
        __syncthreads();
        for (int it = tid; it < 63 * 16; it += NTHREADS) {
            const int ti = it >> 4, cb = ((it >> 2) & 3) * 4, c2b = (it & 3) * 4, tau = ti - 31, n = tau < 0 ? -tau : tau;
            f32x2_t sacc[4][2];
#pragma unroll
            for (int i = 0; i < 4; ++i) { sacc[i][0] = (f32x2_t){0.f, 0.f}; sacc[i][1] = (f32x2_t){0.f, 0.f}; }
            for (int d = 0; d < 2; ++d) {
                if (d == 0 ? (tau < 0) : (tau > 0)) continue;
                for (int p = 0; p < 64; ++p) {
                    const f32x2_t lam = *(const LAS f32x2_t*)(LP + ((d * 64 + p) * 33 + n) * 2);
                    const f32x4 brv = *(const LAS f32x4*)(BB + (d * 64 + p) * 16 + c2b), biv = *(const LAS f32x4*)(BB + 2048 + (d * 64 + p) * 16 + c2b);
                    const f32x2_t br0 = {brv[0], brv[1]}, br1 = {brv[2], brv[3]}, bi0 = {biv[0], biv[1]}, bi1 = {biv[2], biv[3]};
#pragma unroll
                    for (int i = 0; i < 4; ++i) {
                        const f32x2_t cc = *(const LAS f32x2_t*)(CC + ((d * 16 + cb + i) * 64 + p) * 2);
                        const float xr = cc[0] * lam[0] - cc[1] * lam[1], xi = cc[0] * lam[1] + cc[1] * lam[0];
                        const f32x2_t xr2 = {xr, xr}, xi2 = {-xi, -xi};
                        sacc[i][0] = __builtin_elementwise_fma(xr2, br0, sacc[i][0]); sacc[i][0] = __builtin_elementwise_fma(xi2, bi0, sacc[i][0]);
                        sacc[i][1] = __builtin_elementwise_fma(xr2, br1, sacc[i][1]); sacc[i][1] = __builtin_elementwise_fma(xi2, bi1, sacc[i][1]);
                    }
                }
            }
#pragma unroll
            for (int i = 0; i < 4; ++i) { LAS float* kp = KT + (ti * 16 + cb + i) * 16 + c2b; kp[0] = sacc[i][0][0]; kp[1] = sacc[i][0][1]; kp[2] = sacc[i][1][0]; kp[3] = sacc[i][1][1]; }
        }
        __syncthreads();
        for (int it = tid; it < 512 * 96; it += NTHREADS) {
            const int rl = it / 96, oc = it % 96, nrow = rl, t = nrow >> 4, c = nrow & 15, k0 = oc * 8;
            float v[8];
            if (k0 < 512) {
                const int s = k0 >> 4, c0 = k0 & 15, tau = t - s;
                const float dsk = P.ssm_d[l * DM + g * 16 + c];
const f32x4 kv[2] = {*(const LAS f32x4*)(KT + ((tau + 31) * 16 + c) * 16 + c0), *(const LAS f32x4*)(KT + ((tau + 31) * 16 + c) * 16 + c0 + 4)};
#pragma unroll
                for (int q = 0; q < 8; ++q) v[q] = kv[q >> 2][q & 3] + ((tau == 0 && c == c0 + q) ? dsk : 0.f);
            } else {
                const int j0 = k0 - 512, d = j0 >> 7, part = (j0 >> 6) & 1, p0 = j0 & 63, e = d ? (TCH - t) : (t + 1);
#pragma unroll
                for (int q = 0; q < 8; ++q) { const int p = p0 + q;
                    const float cr = CC[((d * 16 + c) * 64 + p) * 2], ci = CC[((d * 16 + c) * 64 + p) * 2 + 1];
                    const float lr = LP[((d * 64 + p) * 33 + e) * 2], li = LP[((d * 64 + p) * 33 + e) * 2 + 1];
                    v[q] = part ? -(cr * li + ci * lr) : (cr * lr - ci * li); }
            }
            *(u32x4*)(Mg + ((size_t)g * 512 + nrow) * UKK + k0) = pack8(v);
        }
        for (int it = tid; it < 256 * 64; it += NTHREADS) {
            const int rl = it >> 6, oc = it & 63, d = rl >> 7, part = (rl >> 6) & 1, p = rl & 63, k0 = oc * 8, s = k0 >> 4, c0 = k0 & 15, e = d ? s : (TCH - 1 - s);
            const float lr = LP[((d * 64 + p) * 33 + e) * 2], li = LP[((d * 64 + p) * 33 + e) * 2 + 1];
            float v[8];
#pragma unroll
            for (int q = 0; q < 8; ++q) { const float br = BB[(d * 64 + p) * 16 + c0 + q], bi = BB[2048 + (d * 64 + p) * 16 + c0 + q];
                v[q] = part ? (lr * bi + li * br) : (lr * br - li * bi); }
            *(u32x4*)(Bt + ((size_t)g * 256 + rl) * 512 + k0) = pack8(v);
        }
        __syncthreads();
    }
    LAS float* tile = (LAS float*)lds;
    const int kr = tid >> 6, nc = (tid & 63) * 4, nr = tid >> 1, ko = (tid & 1) * 32;
#define TR_DECODE(t_, src_, dst_, K_, N_, k0_, n0_) do { int tk_, tn_; \
        if ((t_) < 1536) { src_ = P.w_in + (size_t)l * DM * INC; dst_ = (bf16_t*)(ws + OFF_WINT); K_ = DM; N_ = INC; tk_ = (t_) / 48; tn_ = (t_) % 48; } \
        else if ((t_) < 2560) { const int q = (t_) - 1536, mi = q >> 8, r = q & 255; tk_ = r >> 3; tn_ = r & 7; K_ = DM; N_ = DM; \
            src_ = (mi == 0 ? P.glu_w : mi == 1 ? P.proj_a : mi == 2 ? P.proj_b : P.w_out) + (size_t)l * DM * DM; \
            dst_ = (bf16_t*)(ws + (mi == 0 ? OFF_GLUT : mi == 1 ? OFF_PAT : mi == 2 ? OFF_PBT : OFF_WOT)); } \
        else { const int q = (t_) - 2560, gi = q >> 4, r = q & 15; tk_ = r >> 1; tn_ = r & 1; K_ = 512; N_ = 512; \
            src_ = P.pool_w + (size_t)(l * 4 + gi) * 512 * 512; dst_ = (bf16_t*)(ws + OFF_POOLT) + (size_t)gi * 512 * 512; } \
        k0_ = tk_ * 64; n0_ = tn_ * 256; } while (0)
    constexpr int TSPLIT = 2368;
    const bool s5blk = (int)blockIdx.x < nS, two = (int)gridDim.x > nS;
    int t_end = two ? (s5blk ? 2624 : TSPLIT) : 2624, t_step = two ? (s5blk ? nS : (int)gridDim.x - nS) : (int)gridDim.x;
    f32x4 v[8];
    int t = two ? (s5blk ? TSPLIT + (int)blockIdx.x : (int)blockIdx.x - nS) : (int)blockIdx.x;
    asm volatile("" : "+s"(t), "+s"(t_end), "+s"(t_step));
    const float* src; bf16_t* dst; int K, N, k0, n0;
    if (t < t_end) { TR_DECODE(t, src, dst, K, N, k0, n0);
#pragma unroll
        for (int i = 0; i < 8; ++i) v[i] = *(const f32x4*)(src + (size_t)(k0 + kr + 8 * i) * N + n0 + nc); }
    while (t < t_end) {
#pragma unroll
        for (int i = 0; i < 8; ++i) *(LAS f32x4*)(tile + (kr + 8 * i) * 260 + nc) = v[i];
        __syncthreads();
        bf16_t* cdst = dst; const int cK = K, ck0 = k0, cn0 = n0;
        t += t_step;
        if (t < t_end) { TR_DECODE(t, src, dst, K, N, k0, n0);
#pragma unroll
            for (int i = 0; i < 8; ++i) v[i] = *(const f32x4*)(src + (size_t)(k0 + kr + 8 * i) * N + n0 + nc); }
#pragma unroll
        for (int q4 = 0; q4 < 4; ++q4) { float o[8];
#pragma unroll
            for (int q = 0; q < 8; ++q) o[q] = tile[(ko + q4 * 8 + q) * 260 + nr];
            *(u32x4*)(cdst + (size_t)(cn0 + nr) * cK + ck0 + ko + q4 * 8) = pack8(o); }
        __syncthreads();
    }
#undef TR_DECODE
}

constexpr int PH_PER_LAYER = 13, N_PHASES = 2 * PH_PER_LAYER + 1;

__device__ __forceinline__ void run_phase(const Params& P, int ph, LAS unsigned char* lds) {
    int tid = threadIdx.x; asm volatile("" : "+v"(tid));
    int c = blockIdx.x; asm volatile("" : "+s"(c));
    size_t zoff = 0; asm volatile("" : "+s"(zoff));
    unsigned char* ws = P.ws + zoff;
    bf16_t* WinT = (bf16_t*)(ws + OFF_WINT); bf16_t* GluT = (bf16_t*)(ws + OFF_GLUT); bf16_t* PaT = (bf16_t*)(ws + OFF_PAT); bf16_t* PbT = (bf16_t*)(ws + OFF_PBT);
    bf16_t* WoT = (bf16_t*)(ws + OFF_WOT); bf16_t* PoolT = (bf16_t*)(ws + OFF_POOLT); bf16_t* Mg = (bf16_t*)(ws + OFF_MG); bf16_t* Bt = (bf16_t*)(ws + OFF_BT);
    bf16_t* H = (bf16_t*)(ws + OFF_H); bf16_t* Ug = (bf16_t*)(ws + OFF_RA); bf16_t* UB = (bf16_t*)(ws + OFF_RA); bf16_t* SGA = (bf16_t*)(ws + OFF_RA);
    bf16_t* SZA = (bf16_t*)(ws + OFF_RB); float* Ebuf = (float*)(ws + OFF_RC); bf16_t* YS5 = (bf16_t*)(ws + OFF_RC); bf16_t* PP = (bf16_t*)(ws + OFF_RC); bf16_t* SGB = (bf16_t*)(ws + OFF_RC);
    bf16_t* SZB = (bf16_t*)(ws + OFF_RD);
    const int G = gridDim.x;
    bf16_t* X1B = (bf16_t*)P.out;
    float* X2 = (float*)(ws + OFF_RB);
    if (ph == 2 * PH_PER_LAYER) { rms_phase<false>(tid, X2, X2, P.final_norm_w, P.out); return; }
    const int l = ph / PH_PER_LAYER, sp = ph % PH_PER_LAYER;
    const float* xin0 = P.x_prompt;
    const float* xin1 = P.x_sample - (size_t)SEQL * DM;
    switch (sp) {
    case 0: prep_phase(tid, ws, P, l, lds); if (l == 0) rms_phase<true>(tid, xin0, xin1, P.norm_w, H); else rms_phase_b(tid, X1B, P.norm_w + DM, H); break;
    case 1: { pg8::Gemm g{H, WinT, DM, DM, DM, 0, 0, 0}; pg8::StaticOrder S; S.init(NTOK, 4096, G, c); S.rev = sp & 1;
        pg8::EpiB<pg8::E_G1A> E{Ug, SZA, nullptr, nullptr}; pg8::gemm_phase(lds, tid, g, S, E); } break;
    case 2: { pg8::Gemm g{Ug, Bt, UKK, 512, 512, 0, (size_t)UROWS * UKK, (size_t)256 * 512}; pg8::BatchOrder S; S.init(SGRP, 3, 1, G, c); S.rev = sp & 1;
        pg8::EpiF<pg8::F_S5P1> E{Ebuf, nullptr, nullptr}; pg8::gemm_phase(lds, tid, g, S, E); } break;
    case 3: {
        asm volatile("s_waitcnt vmcnt(0)" ::: "memory"); __syncthreads();
        __builtin_amdgcn_fence(__ATOMIC_ACQUIRE, "agent"); asm volatile("s_waitcnt vmcnt(0)" ::: "memory");
        pg8::BatchOrder S; S.init(SGRP, 3, 1, G, c); S.rev = 0;
        const int w = tid >> 6; pg8::Unit u; if (w < 4 && S.next(w >> 1, u)) carry_wave(P, l, Ebuf, Ug, u.b, u.pm, w & 1, tid & 63); } break;
    case 4: { pg8::Gemm g{Ug, Mg, UKK, UKK, UKK, 0, (size_t)UROWS * UKK, (size_t)512 * UKK}; pg8::BatchOrder S; S.init(SGRP, 3, 2, G, c); S.rev = sp & 1;
        pg8::EpiB<pg8::E_S5P2> E{YS5, nullptr, nullptr, nullptr}; pg8::gemm_phase(lds, tid, g, S, E); } break;
    case 5: { pg8::Gemm g{YS5, GluT, DM, DM, DM, 3, 0, 0}; pg8::StaticOrder S; S.init(NTOK, DM, G, c); S.rev = sp & 1;
        pg8::EpiB<pg8::E_GLU> E{SZA, nullptr, YS5, P.glu_b + l * DM}; pg8::gemm_phase(lds, tid, g, S, E); } break;
    case 6: { pg8::Gemm g{H, WinT + (size_t)4096 * DM, DM, DM, DM, 0, 0, 0}; pg8::StaticOrder S; S.init(NTOK, 4096, G, c); S.rev = sp & 1;
        pg8::EpiB<pg8::E_G1B> E{UB, SZB, nullptr, nullptr}; pg8::gemm_phase(lds, tid, g, S, E); } break;
    case 7: poole_phase(tid, UB, PP, lds); break;
    case 8: { pg8::Gemm g{PP, PoolT, DM, 512, 512, 1, 0, 0}; pg8::StaticOrder S; S.init(NTOK, DM, G, c); S.rev = 1;
        pg8::EpiB<pg8::E_POOL> E{SZB, nullptr, nullptr, P.pool_scale + l * DM}; pg8::gemm_phase(lds, tid, g, S, E); } break;
    case 9: { pg8::Gemm g{SZA, PaT, DM, DM, DM, 0, 0, 0}; pg8::StaticOrder S; S.init(NTOK, DM, G, c); S.rev = 0;
        pg8::EpiB<pg8::E_RAW> E{SGA, nullptr, nullptr, nullptr}; pg8::gemm_phase(lds, tid, g, S, E); } break;
    case 10: { pg8::Gemm g{SZB, PbT, DM, DM, DM, 0, 0, 0}; pg8::StaticOrder S; S.init(NTOK, DM, G, c); S.rev = 0;
        pg8::EpiB<pg8::E_RAW> E{SGB, nullptr, nullptr, nullptr}; pg8::gemm_phase(lds, tid, g, S, E); } break;
    case 11: { pg8::Gemm g{H, WinT + (size_t)8192 * DM, DM, DM, DM, 2, 0, 0}; pg8::StaticOrder S; S.init(NTOK, 4096, G, c); S.rev = 1;
        pg8::EpiB<pg8::E_MERGE> E{SGA, nullptr, SGB, P.gate_b + l * 2 * DM}; pg8::gemm_phase(lds, tid, g, S, E); } break;
    case 12: { pg8::Gemm g{SGA, WoT, DM, DM, DM, 0, 0, 0}; pg8::StaticOrder S; S.init(NTOK, DM, G, c); S.rev = 0;
        if (l == 0) { pg8::EpiB<pg8::E_RES0> E{X1B, nullptr, nullptr, xin0, xin1, nullptr}; pg8::gemm_phase(lds, tid, g, S, E); }
        else { pg8::EpiB<pg8::E_RES1> E{nullptr, nullptr, X1B, nullptr, nullptr, X2}; pg8::gemm_phase(lds, tid, g, S, E); } } break;
    }
}


#define XB_TMO      128
#define XB_XCNT(j)  (256  + 64 * (j))
#define XB_XSUB(j)  (1280 + 64 * (j))
#define XB_XGEN(j)  (2304 + 64 * (j))
#define XB_TOP      3328
#define XB_TOPGEN   3392
#define XCD_BAR_WORDS 3456
#define XB_SPIN_CAP (1u << 18)
__device__ __forceinline__ unsigned xb_ld(unsigned* p)              { return __hip_atomic_load(p, __ATOMIC_RELAXED, __HIP_MEMORY_SCOPE_AGENT); }
__device__ __forceinline__ unsigned xb_add(unsigned* p, unsigned v) { return __hip_atomic_fetch_add(p, v, __ATOMIC_RELAXED, __HIP_MEMORY_SCOPE_AGENT); }
__device__ __forceinline__ unsigned xb_xcc_id() { return (unsigned)__builtin_amdgcn_s_getreg((3 << 11) | 20) & 0xFu; }
#define XB_SPIN(cond, bar) do { unsigned _sp = 0; while (cond) { __builtin_amdgcn_s_sleep(1); \
    if ((++_sp & 255u) == 0u) { if (xb_ld(&(bar)[XB_TMO])) break; if (_sp > XB_SPIN_CAP) { atomicAdd(&(bar)[XB_TMO], 1u); break; } } } } while (0)
struct XcdBarrier { unsigned* bar; unsigned x; volatile LAS unsigned* st; };
__device__ __forceinline__ XcdBarrier xcd_barrier_post(unsigned* bar, volatile LAS unsigned* st) {
    XcdBarrier b; b.bar = bar; b.x = xb_xcc_id(); b.st = st;
    if (threadIdx.x == 0) (void)xb_add(&bar[XB_XCNT(b.x)], 1u);
    return b;
}
__device__ __forceinline__ void xcd_barrier_complete(unsigned* bar, unsigned x, unsigned& nloc, unsigned& nx) {
    const unsigned G = gridDim.x * gridDim.y * gridDim.z;
    unsigned sum, cnt, mine, sp = 0u;
    for (;;) {
        sum = 0u; cnt = 0u; mine = 0u;
#pragma unroll
        for (unsigned j = 0; j < 16; ++j) { const unsigned c = xb_ld(&bar[XB_XCNT(j)]); sum += c; cnt += (c > 0u) ? 1u : 0u; mine = (j == x) ? c : mine; }
        if (sum == G) break;
        __builtin_amdgcn_s_sleep(1);
        if ((++sp & 255u) == 0u) { if (xb_ld(&bar[XB_TMO])) break; if (sp > XB_SPIN_CAP) { atomicAdd(&bar[XB_TMO], 1u); break; } }
    }
    nloc = mine > 0u ? mine : 1u; nx = cnt > 0u ? cnt : 1u;
}
__device__ __forceinline__ void xcd_barrier(const XcdBarrier& b) {
    asm volatile("s_waitcnt vmcnt(0)" ::: "memory");
    __syncthreads();
    if (threadIdx.x == 0) {
        unsigned* bar = b.bar;
        __builtin_amdgcn_s_waitcnt(0);
        unsigned nloc = b.st[0], nx = b.st[1];
        if (nloc == 0u) { xcd_barrier_complete(bar, b.x, nloc, nx); b.st[0] = nloc; b.st[1] = nx; }
        const unsigned old = xb_add(&bar[XB_XSUB(b.x)], 1u);
        const unsigned gen = old / nloc;
        if (old + 1u == (gen + 1u) * nloc) {
            __builtin_amdgcn_fence(__ATOMIC_RELEASE, "agent");
            asm volatile("s_waitcnt vmcnt(0)" ::: "memory");
            const unsigned og = xb_add(&bar[XB_TOP], 1u);
            const unsigned tg = og / nx;
            if (og + 1u == (tg + 1u) * nx) xb_add(&bar[XB_TOPGEN], 1u);
            else XB_SPIN(xb_ld(&bar[XB_TOPGEN]) == tg, bar);
            __builtin_amdgcn_fence(__ATOMIC_ACQUIRE, "agent");
            xb_add(&bar[XB_XGEN(b.x)], 1u);
            asm volatile("s_waitcnt vmcnt(0)" ::: "memory");
        } else {
            XB_SPIN(xb_ld(&bar[XB_XGEN(b.x)]) == gen, bar);
            __builtin_amdgcn_fence(__ATOMIC_ACQUIRE, "agent");
            asm volatile("s_waitcnt vmcnt(0)" ::: "memory");
        }
    }
    __syncthreads();
}
constexpr size_t OFF_BAR = 740 * MiB;

__global__ void __launch_bounds__(NTHREADS, 2) mega(Params P) {
    extern __shared__ __attribute__((aligned(16))) unsigned char lds_raw[];
    LAS unsigned char* lds = (LAS unsigned char*)lds_raw;
    cg::grid_group grid = cg::this_grid();
    volatile LAS unsigned* st = (volatile LAS unsigned*)(lds + 131072);
    if (threadIdx.x == 0) { st[0] = 0u; st[1] = 0u; }
    __syncthreads();
    XcdBarrier xb = xcd_barrier_post((unsigned*)(P.ws + OFF_BAR), st);
    for (int ph = P.ph_lo; ph < P.ph_hi; ++ph) {
        run_phase(P, ph, lds);
        const int spn = ph % PH_PER_LAYER;
        const bool local_seam = ph < 2 * PH_PER_LAYER && (spn == 2 || spn == 5 || spn == 8);
        if (ph + 1 < P.ph_hi && !local_seam) { if (P.ph_lo < 0) grid.sync(); else xcd_barrier(xb); }
    }
}

extern "C" void kernel_launch(void* const* d_in, const int* in_sizes, int n_in, void* d_out, int out_size, void* d_ws, size_t ws_size, hipStream_t stream) {
    static int grid_blocks = 0;
    if (!grid_blocks) {
        if (n_in != 21 || ws_size < OFF_BAR + XCD_BAR_WORDS * 4) { fprintf(stderr, "kernel_launch: unexpected n_in %d or ws_size %zu (< %zu)\n", n_in, ws_size, (size_t)WS_END); grid_blocks = -1; return; }
        int dev = 0, cus = 0, per_cu = 0;
        hipGetDevice(&dev);
        hipDeviceGetAttribute(&cus, hipDeviceAttributeMultiprocessorCount, dev);
        if (hipFuncSetAttribute((const void*)mega, hipFuncAttributeMaxDynamicSharedMemorySize, LDS_BYTES) != hipSuccess) { fprintf(stderr, "kernel_launch: hipFuncSetAttribute failed\n"); grid_blocks = -1; return; }
        if (hipOccupancyMaxActiveBlocksPerMultiprocessor(&per_cu, (const void*)mega, NTHREADS, LDS_BYTES) != hipSuccess || per_cu < 1) { fprintf(stderr, "kernel_launch: occupancy query gave %d\n", per_cu); per_cu = 1; }
        (void)hipGetLastError();
        grid_blocks = cus * per_cu;
    }
    if (grid_blocks < 0) return;
    hipMemsetAsync((char*)d_ws + OFF_BAR, 0, XCD_BAR_WORDS * 4, stream);
    Params p{};
    const float** pp = (const float**)&p;
    for (int i = 0; i < 21; ++i) pp[i] = (const float*)d_in[i];
    p.out = (float*)d_out; p.ws = (unsigned char*)d_ws;
    p.ph_lo = 0; p.ph_hi = N_PHASES;
    void* args[] = {&p};
    hipError_t e = hipLaunchCooperativeKernel((const void*)mega, dim3(grid_blocks), dim3(NTHREADS), args, LDS_BYTES, stream);
    if (e != hipSuccess) fprintf(stderr, "cooperative launch failed: %s (grid %d)\n", hipGetErrorString(e), grid_blocks);
}
```
